# Optimizing an MI355X kernel written in HIP

```python
import math
import jax, jax.numpy as jnp
from jax import lax
import numpy as np

D_MODEL = 1024
BATCH = 16
SEQ = 4096
DEPTH = 4

RET_HEADS = 4
RET_DK = 64
RET_DV = 64
RET_CHUNK = 128
RET_W = RET_HEADS * RET_DV
ROPE_BASE = 10000.0

S5_WIDTH = 256
S5_GROUP = 16
S5_GROUPS = S5_WIDTH // S5_GROUP
S5_STATE = 64
DT_MIN = 1e-3
DT_MAX = 1e-1

GLA_HEADS = 4
GLA_DK = 64
GLA_DV = 128
GLA_RANK = 16
GLA_TAU = 16.0
GLA_CHUNK = 64
GLA_KW = GLA_HEADS * GLA_DK
GLA_VW = GLA_HEADS * GLA_DV

N_BRANCH = 3
D_FF = 4 * D_MODEL
EPS = 1e-6

IN_SPLITS = (RET_HEADS * RET_DK, RET_HEADS * RET_DK, RET_W, RET_W, S5_WIDTH,
             GLA_KW, GLA_KW, GLA_VW, GLA_RANK, GLA_VW)
D_IN = 4 * RET_W + S5_WIDTH + 2 * GLA_KW + 2 * GLA_VW + GLA_RANK

kernel_name = "hybrid_retention_s5_gla_encoder"


def rmsnorm(x, g):
    xf = x.astype(jnp.float32)
    y = xf * lax.rsqrt(jnp.mean(xf * xf, axis=-1, keepdims=True) + EPS)
    return (y * g.astype(jnp.float32)).astype(x.dtype)


def head_norm(o, g, center, dtype):
    if center:
        o = o - jnp.mean(o, axis=-1, keepdims=True)
    o = o * lax.rsqrt(jnp.mean(o * o, axis=-1, keepdims=True) + EPS)
    Bn, L = o.shape[0], o.shape[1]
    return (o.reshape(Bn, L, -1) * g.astype(jnp.float32)).astype(dtype)


def rotary(x, pos):
    d = x.shape[-1]
    inv = 1.0 / (ROPE_BASE ** (jnp.arange(0, d, 2, dtype=jnp.float32) / d))
    ang = pos.astype(jnp.float32)[:, None] * inv[None, :]
    cos = jnp.cos(ang)[None, :, None, :]
    sin = jnp.sin(ang)[None, :, None, :]
    xf = x.astype(jnp.float32)
    x1, x2 = xf[..., : d // 2], xf[..., d // 2:]
    return jnp.concatenate([x1 * cos - x2 * sin, x1 * sin + x2 * cos], axis=-1)


def _retention_state_scan(kv, dec, reverse):
    def step(S, kv_n):
        return dec[None, :, None, None] * S + kv_n, S
    _, prev = lax.scan(step, jnp.zeros_like(kv[:, 0]), jnp.moveaxis(kv, 1, 0), reverse=reverse)
    return jnp.moveaxis(prev, 0, 1)


def retention_bidir(q, k, v):
    Bn, L, H, dk = q.shape
    dv = v.shape[-1]
    C = RET_CHUNK
    N = L // C
    f32 = jnp.float32
    q = q.astype(f32).reshape(Bn, N, C, H, dk) * (dk ** -0.5)
    k = k.astype(f32).reshape(Bn, N, C, H, dk)
    v = v.astype(f32).reshape(Bn, N, C, H, dv)
    log_g = jnp.log1p(-jnp.exp2(-5.0 - jnp.arange(H, dtype=f32)))
    idx = jnp.arange(C, dtype=f32)
    dmat = jnp.exp(log_g[:, None, None] * jnp.abs(idx[:, None] - idx[None, :]))
    s = jnp.einsum('bnihd,bnjhd->bnhij', q, k) * dmat
    o = jnp.einsum('bnhij,bnjhe->bnihe', s, v)
    w_f = jnp.exp(log_g[None, :] * (C - 1.0 - idx)[:, None])
    w_b = jnp.exp(log_g[None, :] * idx[:, None])
    kv_f = jnp.einsum('bnjhd,jh,bnjhe->bnhde', k, w_f, v)
    kv_b = jnp.einsum('bnjhd,jh,bnjhe->bnhde', k, w_b, v)
    dec = jnp.exp(log_g * C)
    S_f = _retention_state_scan(kv_f, dec, False)
    S_b = _retention_state_scan(kv_b, dec, True)
    q_f = jnp.exp(log_g[None, :] * (idx + 1.0)[:, None])
    q_b = jnp.exp(log_g[None, :] * (C - idx)[:, None])
    o = (o + jnp.einsum('bnihd,bnhde->bnihe', q * q_f[:, :, None], S_f)
           + jnp.einsum('bnihd,bnhde->bnihe', q * q_b[:, :, None], S_b))
    return o.reshape(Bn, L, H, dv)


def gla_chunked(q, k, v, log_a, strict):
    Bn, L, H, dk = q.shape
    dv = v.shape[-1]
    C = GLA_CHUNK
    N = L // C
    f32 = jnp.float32
    q = q.astype(f32).reshape(Bn, N, C, H, dk)
    k = k.astype(f32).reshape(Bn, N, C, H, dk)
    v = v.astype(f32).reshape(Bn, N, C, H, dv)
    b = jnp.cumsum(log_a.astype(f32).reshape(Bn, N, C, H, dk), axis=2)
    b_last = b[:, :, -1]
    q_in = q * jnp.exp(b)
    k_in = k * jnp.exp(-b)
    s = jnp.einsum('bnihd,bnjhd->bnhij', q_in, k_in)
    mask = jnp.tril(jnp.ones((C, C), dtype=bool), k=-1 if strict else 0)
    s = jnp.where(mask, s, 0.0)
    o = jnp.einsum('bnhij,bnjhe->bnihe', s, v)
    k_st = k * jnp.exp(b_last[:, :, None] - b)
    kv = jnp.einsum('bnjhd,bnjhe->bnhde', k_st, v)

    def step(S, inp):
        kv_n, dec_n = inp
        return dec_n[..., None] * S + kv_n, S

    _, S_prev = lax.scan(step, jnp.zeros_like(kv[:, 0]),
                         (jnp.moveaxis(kv, 1, 0), jnp.moveaxis(jnp.exp(b_last), 1, 0)))
    o = o + jnp.einsum('bnihd,bnhde->bnihe', q_in, jnp.moveaxis(S_prev, 0, 1))
    return o.reshape(Bn, L, H, dv)


def _lin_rec(e_i, e_j):
    a_i, b_i = e_i
    a_j, b_j = e_j
    return a_j * a_i, a_j * b_i + b_j


def s5_direction(u, lam_re, lam_im, log_dt, b_re, b_im, c_re, c_im, reverse):
    f32 = jnp.float32
    L = u.shape[1]
    lam = lax.complex(lam_re.astype(f32), lam_im.astype(f32))
    dt = jnp.exp(log_dt.astype(f32))[:, None]
    lam_bar = jnp.exp(lam * dt)
    Bm = lax.complex(b_re.astype(f32), b_im.astype(f32))
    B_bar = ((lam_bar - 1.0) / lam)[..., None] * Bm
    Bu = jnp.einsum('blgc,gpc->blgp', u.astype(jnp.complex64), B_bar)
    a = jnp.broadcast_to(lam_bar[None, None], (1, L) + lam_bar.shape)
    _, xs = lax.associative_scan(_lin_rec, (a, Bu), axis=1, reverse=reverse)
    Cm = lax.complex(c_re.astype(f32), c_im.astype(f32))
    return jnp.real(jnp.einsum('blgp,gcp->blgc', xs, Cm))


def setup_inputs(seed: int = 0) -> dict:
    key = jax.random.key(seed)
    ks = jax.random.split(key, 32)
    f32 = jnp.float32

    def nrm(k, shape, scale):
        return jax.random.normal(k, shape, f32) * scale

    G, P, Hc = S5_GROUPS, S5_STATE, S5_GROUP
    lam_im_base = (math.pi * jnp.arange(P, dtype=f32))[None, None, None, :]
    return {
        "x": nrm(ks[0], (BATCH, SEQ, D_MODEL), 1.0),
        "norm1_g": 1.0 + nrm(ks[1], (DEPTH, D_MODEL), 0.02),
        "w_in": nrm(ks[2], (DEPTH, D_MODEL, D_IN), D_MODEL ** -0.5),
        "ret_norm_g": 1.0 + nrm(ks[3], (DEPTH, RET_W), 0.02),
        "s5_lam_re": -0.5 + nrm(ks[4], (DEPTH, 2, G, P), 0.01),
        "s5_lam_im": lam_im_base + nrm(ks[5], (DEPTH, 2, G, P), 0.01),
        "s5_log_dt": jax.random.uniform(ks[6], (DEPTH, 2, G), f32, math.log(DT_MIN), math.log(DT_MAX)),
        "s5_b_re": nrm(ks[7], (DEPTH, 2, G, P, Hc), (2 * Hc) ** -0.5),
        "s5_b_im": nrm(ks[8], (DEPTH, 2, G, P, Hc), (2 * Hc) ** -0.5),
        "s5_c_re": nrm(ks[9], (DEPTH, 2, G, Hc, P), (2 * P) ** -0.5 * 4.0),
        "s5_c_im": nrm(ks[10], (DEPTH, 2, G, Hc, P), (2 * P) ** -0.5 * 4.0),
        "s5_d": nrm(ks[11], (DEPTH, S5_WIDTH), 1.0),
        "gla_w_gate": nrm(ks[12], (DEPTH, 2, GLA_RANK, GLA_KW), GLA_RANK ** -0.5),
        "gla_b_gate": nrm(ks[13], (DEPTH, 2, GLA_KW), 0.1),
        "gla_norm_g": 1.0 + nrm(ks[14], (DEPTH, GLA_VW), 0.02),
        "w_branch_a": nrm(ks[15], (DEPTH, RET_W, D_MODEL), RET_W ** -0.5),
        "w_branch_b": nrm(ks[16], (DEPTH, S5_WIDTH, 2 * D_MODEL), S5_WIDTH ** -0.5),
        "w_branch_c": nrm(ks[17], (DEPTH, GLA_VW, D_MODEL), GLA_VW ** -0.5),
        "w_merge_gate": nrm(ks[18], (DEPTH, D_MODEL, N_BRANCH * D_MODEL), D_MODEL ** -0.5),
        "b_merge_gate": nrm(ks[19], (DEPTH, N_BRANCH * D_MODEL), 0.1),
        "w_out": nrm(ks[20], (DEPTH, D_MODEL, D_MODEL), D_MODEL ** -0.5),
        "norm2_g": 1.0 + nrm(ks[21], (DEPTH, D_MODEL), 0.02),
        "w_ff1": nrm(ks[22], (DEPTH, D_MODEL, D_FF), D_MODEL ** -0.5),
        "w_ff2": nrm(ks[23], (DEPTH, D_FF, D_MODEL), D_FF ** -0.5),
        "final_norm_g": 1.0 + nrm(ks[24], (D_MODEL,), 0.02),
    }


def reference(x, norm1_g, w_in, ret_norm_g, s5_lam_re, s5_lam_im, s5_log_dt, s5_b_re, s5_b_im,
              s5_c_re, s5_c_im, s5_d, gla_w_gate, gla_b_gate, gla_norm_g, w_branch_a, w_branch_b,
              w_branch_c, w_merge_gate, b_merge_gate, w_out, norm2_g, w_ff1, w_ff2, final_norm_g):
    Bn, L, D = x.shape
    dt = x.dtype
    pos = jnp.arange(L)
    split_idx = [int(s) for s in np.cumsum(IN_SPLITS)[:-1]]
    for l in range(DEPTH):
        h = rmsnorm(x, norm1_g[l])
        z = h @ w_in[l]
        a_q, a_k, a_v, a_g, b_u, c_q, c_k, c_v, c_lr, c_r = jnp.split(z, split_idx, axis=-1)

        rq = rotary(a_q.reshape(Bn, L, RET_HEADS, RET_DK), pos)
        rk = rotary(a_k.reshape(Bn, L, RET_HEADS, RET_DK), pos)
        ro = retention_bidir(rq, rk, a_v.reshape(Bn, L, RET_HEADS, RET_DV))
        ro = head_norm(ro, ret_norm_g[l], True, dt) * jax.nn.silu(a_g)
        br_a = ro @ w_branch_a[l]

        u = b_u.astype(jnp.float32).reshape(Bn, L, S5_GROUPS, S5_GROUP)
        y = (s5_direction(u, s5_lam_re[l, 0], s5_lam_im[l, 0], s5_log_dt[l, 0], s5_b_re[l, 0],
                          s5_b_im[l, 0], s5_c_re[l, 0], s5_c_im[l, 0], False)
             + s5_direction(u, s5_lam_re[l, 1], s5_lam_im[l, 1], s5_log_dt[l, 1], s5_b_re[l, 1],
                            s5_b_im[l, 1], s5_c_re[l, 1], s5_c_im[l, 1], True)
             + s5_d[l].astype(jnp.float32).reshape(S5_GROUPS, S5_GROUP) * u)
        y = jax.nn.gelu(y.reshape(Bn, L, S5_WIDTH), approximate=False).astype(dt)
        glu = y @ w_branch_b[l]
        br_b = glu[..., :D] * jax.nn.sigmoid(glu[..., D:])

        gq = c_q.reshape(Bn, L, GLA_HEADS, GLA_DK) * (GLA_DK ** -0.5)
        gk = c_k.reshape(Bn, L, GLA_HEADS, GLA_DK)
        gv = c_v.reshape(Bn, L, GLA_HEADS, GLA_DV)
        lr = c_lr.astype(jnp.float32)
        la_f = (jax.nn.log_sigmoid(lr @ gla_w_gate[l, 0].astype(jnp.float32)
                                   + gla_b_gate[l, 0].astype(jnp.float32)) / GLA_TAU
                ).reshape(Bn, L, GLA_HEADS, GLA_DK)
        la_b = (jax.nn.log_sigmoid(lr @ gla_w_gate[l, 1].astype(jnp.float32)
                                   + gla_b_gate[l, 1].astype(jnp.float32)) / GLA_TAU
                ).reshape(Bn, L, GLA_HEADS, GLA_DK)
        go_f = gla_chunked(gq, gk, gv, la_f, False)
        go_b = jnp.flip(gla_chunked(jnp.flip(gq, 1), jnp.flip(gk, 1), jnp.flip(gv, 1),
                                    jnp.flip(la_b, 1), True), 1)
        go = head_norm(go_f + go_b, gla_norm_g[l], False, dt) * jax.nn.silu(c_r)
        br_c = go @ w_branch_c[l]

        gates = jax.nn.sigmoid(h @ w_merge_gate[l] + b_merge_gate[l])
        g_a, g_b, g_c = jnp.split(gates, N_BRANCH, axis=-1)
        x = x + (g_a * br_a + g_b * br_b + g_c * br_c) @ w_out[l]

        h2 = rmsnorm(x, norm2_g[l])
        x = x + jnp.square(jax.nn.relu(h2 @ w_ff1[l])) @ w_ff2[l]
    return rmsnorm(x, final_norm_g)
```

```cpp
#include <hip/hip_runtime.h>
#include <hip/hip_cooperative_groups.h>
#include <cstdio>
#include <cstdint>
namespace cg = cooperative_groups;

#define LAS __attribute__((address_space(3)))
typedef unsigned short bf16_t;
typedef short bf16x8 __attribute__((ext_vector_type(8)));
typedef float f32x4 __attribute__((ext_vector_type(4)));
typedef float f32x2 __attribute__((ext_vector_type(2)));
typedef unsigned u32x4 __attribute__((ext_vector_type(4)));
typedef unsigned u32x2 __attribute__((ext_vector_type(2)));

#ifndef EN_A
#define EN_A 1
#endif
#ifndef EN_B
#define EN_B 1
#endif
#ifndef EN_C
#define EN_C 1
#endif

constexpr int NTOK = 65536, DM = 1024, SEQ = 4096, DEPTH = 4, DFF = 4096;
constexpr int ZS = 3072;
constexpr int C_RQ = 0, C_RK = 256, C_RV = 512, C_RG = 768, C_SU = 1024, C_GQ = 1280, C_GK = 1536, C_GV = 1792, C_GR = 2304, C_LR = 2816;
constexpr int LDS_BYTES = 131072 + 16;
constexpr size_t ZR_OFF = 0, ZG_OFF = (size_t)65536 * 1024, ZL_OFF = ZG_OFF + (size_t)65536 * 1536;
constexpr float EPS = 1e-6f;

constexpr size_t WS_WZ = 0;
constexpr size_t WS_WG = WS_WZ + 6291456;
constexpr size_t WS_WA = WS_WG + 6291456;
constexpr size_t WS_WB = WS_WA + 524288;
constexpr size_t WS_WC = WS_WB + 1048576;
constexpr size_t WS_WO = WS_WC + 1048576;
constexpr size_t WS_W1 = WS_WO + 2097152;
constexpr size_t WS_W2 = WS_W1 + 8388608;
constexpr size_t WS_T1 = WS_W2 + 8388608;
constexpr size_t WS_T2 = WS_T1 + 8388608;
constexpr size_t WS_UC = WS_T2 + 41943040;
constexpr size_t WS_XL = WS_UC + 41943040;
constexpr size_t WS_H  = WS_XL + 16777216;
constexpr size_t WS_Z  = WS_H + 134217728;
constexpr size_t WS_RO = WS_Z + 402653184;
constexpr size_t WS_Y  = WS_RO + 33554432;
constexpr size_t WS_GO = WS_Y + 33554432;
constexpr size_t WS_GST = WS_GO + 67108864;
constexpr size_t WS_RST = WS_GST + 134217728;
constexpr size_t WS_GDEC = WS_RST + 67108864;
constexpr size_t WS_CTL = WS_GDEC + 2097152;
constexpr size_t WS_END = WS_CTL + 16384;

struct Params { const float* in[25]; float* out; unsigned char* ws; };
struct S5In { const float *lam_re, *lam_im, *log_dt, *b_re, *b_im, *c_re, *c_im, *d; };

__device__ __forceinline__ float bf2f(unsigned b) { return __uint_as_float(b << 16); }
typedef __bf16 bf16v2_t __attribute__((ext_vector_type(2)));
__device__ __forceinline__ unsigned pk2(float lo, float hi) { const f32x2 v = {lo, hi}; const bf16v2_t b = __builtin_convertvector(v, bf16v2_t); return __builtin_bit_cast(unsigned, b); }
__device__ __forceinline__ unsigned f2bf(float f) { return pk2(f, f) & 0xffffu; }

__device__ __forceinline__ float sigmoidf_(float x) { return __builtin_amdgcn_rcpf(1.0f + __expf(-x)); }
__device__ __forceinline__ void sincos_turns(double turns, float& s, float& c) { turns -= rint(turns); const float t = (float)turns; s = __builtin_amdgcn_sinf(t); c = __builtin_amdgcn_cosf(t); }
__device__ __forceinline__ int ltid(int wv) { int lane; asm volatile("v_mbcnt_lo_u32_b32 %0, -1, 0\n\tv_mbcnt_hi_u32_b32 %0, -1, %0" : "=v"(lane)); return wv * 64 + lane; }
__device__ __forceinline__ int lbid() { int t = blockIdx.x; asm volatile("" : "+s"(t)); return t; }
__device__ __forceinline__ int lgdim() { int t = gridDim.x; asm volatile("" : "+s"(t)); return t; }
__device__ __forceinline__ float shx(float v, int mask, int lane) { return __int_as_float(__builtin_amdgcn_ds_bpermute((lane ^ mask) << 2, __float_as_int(v))); }
constexpr double INV2PI = 0.15915494309189533577;
__device__ __forceinline__ f32x2 gelu_pk(f32x2 v) {
    const f32x2 av = __builtin_elementwise_abs(v), d = av * 0.2316418882f + 1.0f;
    f32x2 t; t.x = __builtin_amdgcn_rcpf(d.x); t.y = __builtin_amdgcn_rcpf(d.y);
    f32x2 q = t * 0.5307027145f + (-0.7265760135f); q = q * t + 0.7107068705f; q = q * t + (-0.142248368f); q = q * t + 0.127414796f; q = q * t;
    const f32x2 s = (v * v) * (-0.72134752044f);
    f32x2 e; e.x = __builtin_amdgcn_exp2f(s.x); e.y = __builtin_amdgcn_exp2f(s.y);
    const f32x2 m = v * (q * e), r = v - m;
    f32x2 o; o.x = v.x < 0.f ? m.x : r.x; o.y = v.y < 0.f ? m.y : r.y; return o;
}

namespace pg8 {
constexpr int BM = 256, BK = 64, HALF = 128, HTB = HALF * BK * 2, STAGE_BYTES = 8 * HTB, NXCD = 8, WGM = 8;
__device__ __forceinline__ int lds_byte(int r, int c) { const int st = (r >> 4) * 2 + (c >> 5), rr = r & 15, cc = c & 31, ob = rr * 64 + cc * 2; return st * 1024 + (ob ^ (((ob >> 9) & 1) << 5)); }
__device__ __forceinline__ void stage_rc(int b, int& R, int& C) { const int st = b / 1024, sb = b % 1024, swz = sb ^ (((sb >> 9) & 1) << 5); R = (st >> 1) * 16 + swz / 64; C = (st & 1) * 32 + (swz % 64) / 2; }
__device__ __forceinline__ int perm32(int rho) { const int n = rho >> 4, i = rho & 15; return 8 * (i >> 2) + 4 * n + (i & 3); }

struct Unit { int pm, pn, bt; };

__device__ __forceinline__ void remap(int L, int nM, int nN, int& pm, int& pn) {
    const int nwg = nM * nN; int wgid = L;
    { const int q = nwg / NXCD, r = nwg % NXCD, xcd = wgid % NXCD, off = wgid / NXCD; wgid = (xcd < r ? xcd * (q + 1) : r * (q + 1) + (xcd - r) * q) + off; }
    const int nig = WGM * nN, gid = wgid / nig, fm = gid * WGM, gsz = (nM - fm) < WGM ? (nM - fm) : WGM;
    pm = fm + ((wgid % nig) % gsz); pn = (wgid % nig) / gsz;
}
struct OrderStd {
    const char* A; const char* Bt; int nM, nN, G, c; size_t tA, tB;
    __device__ __forceinline__ void init(const void* A_, int lda, const void* Bt_, int ldb, int M, int N) { A = (const char*)A_; Bt = (const char*)Bt_; nM = M / BM; nN = N / BM; G = lgdim(); c = lbid(); tA = (size_t)BM * lda * 2; tB = (size_t)BM * ldb * 2; }
    __device__ __forceinline__ bool next(int i, Unit& u) const { const long L = (long)i * G + c; if (L >= (long)nM * nN) return false; remap((int)L, nM, nN, u.pm, u.pn); u.bt = 0; return true; }
    __device__ __forceinline__ const char* a_ptr(const Unit& u) const { return A + (size_t)u.pm * tA; }
    __device__ __forceinline__ const char* b_ptr(const Unit& u) const { return Bt + (size_t)u.pn * tB; }
};
struct OrderMerge {
    const char* A; const char* Bt; int nM, G, c; size_t tA, tB;
    __device__ __forceinline__ void init(const void* A_, int lda, const void* Bt_, int ldb, int M) { A = (const char*)A_; Bt = (const char*)Bt_; nM = M / BM; G = lgdim(); c = lbid(); tA = (size_t)BM * lda * 2; tB = (size_t)BM * ldb * 2; }
    __device__ __forceinline__ bool next(int i, Unit& u) const { const int sup = i / 3, seg = i - sup * 3; const long L = (long)sup * G + c; if (L >= (long)nM * 4) return false; int j; remap((int)L, nM, 4, u.pm, j); u.pn = seg * 4 + j; u.bt = 0; return true; }
    __device__ __forceinline__ const char* a_ptr(const Unit& u) const { return A + (size_t)u.pm * tA; }
    __device__ __forceinline__ const char* b_ptr(const Unit& u) const { return Bt + (size_t)u.pn * tB; }
};
struct OrderBatch {
    const char* A; const char* Bt; int nM, nN, G, c; size_t tA, tB, gA, gB;
    __device__ __forceinline__ void init(const void* A_, int lda, size_t gA_, const void* Bt_, int ldb, size_t gB_, int nM_, int nN_) { A = (const char*)A_; Bt = (const char*)Bt_; nM = nM_; nN = nN_; G = lgdim(); c = lbid(); tA = (size_t)BM * lda * 2; tB = (size_t)BM * ldb * 2; gA = gA_; gB = gB_; }
    __device__ __forceinline__ bool next(int i, Unit& u) const {
        const long L = (long)i * G + c; const int per = nM * nN; if (L >= 16L * per) return false;
        const int x = (int)(L & 7), r = (int)(L >> 3), npx = 2 * per;
        const int g = 2 * x + r / per, t = r % per; (void)npx;
        u.bt = g; u.pm = t / nN; u.pn = t % nN; return true; }
    __device__ __forceinline__ const char* a_ptr(const Unit& u) const { return A + (size_t)u.bt * gA + (size_t)u.pm * tA; }
    __device__ __forceinline__ const char* b_ptr(const Unit& u) const { return Bt + (size_t)u.bt * gB + (size_t)u.pn * tB; }
};

template <bool ALIGN_EPI = true, bool SP2 = true, class Epi, class Sched>
__device__ __forceinline__ void gemm_phase(LAS unsigned char* lds, const Sched& S, const Epi& E, const int K, const int lda, const int ldb, const int wv) {
    int tid_ = ltid(wv);
    const int tid = tid_, wid = __builtin_amdgcn_readfirstlane(tid >> 6), lane = tid & 63, wr = wid >> 2, wc = wid & 3, fr = lane & 15, fq = lane >> 4;
    const int nt = K / BK;
    unsigned voffA[2], voffB[2];
#pragma unroll
    for (int i = 0; i < 2; ++i) { int R, C; stage_rc(tid * 16 + i * 8192, R, C); const int Rb = Epi::PERM ? ((R & ~31) + perm32(R & 31)) : R;
        voffA[i] = (unsigned)(R * lda + C) * 2u; voffB[i] = (unsigned)(Rb * ldb + C) * 2u; }
    const size_t kstep = (size_t)(BK * 2);
    const size_t hstepA = (size_t)HALF * lda * 2, hstepB = (size_t)HALF * ldb * 2;
    const unsigned ldsw = (unsigned)wid * 1024u;
    const int aoff = lds_byte(wr * 64 + fr, fq * 8), boff = lds_byte(wc * 32 + fr, fq * 8);
#define PG8_SA(b, h) (((b) * 2 + (h)) * HTB)
#define PG8_SB(b, h) ((4 + (b) * 2 + (h)) * HTB)
#define PG8_STAGE(bufoff, gbase, voff) do { _Pragma("unroll") for (int _i = 0; _i < 2; ++_i) \
        __builtin_amdgcn_global_load_lds((const unsigned*)((const char*)(gbase) + (voff)[_i]), (LAS unsigned*)(lds + (bufoff) + ldsw + _i * 8192), 16, 0, 0); } while (0)
#define PG8_LDA(dst, b, h) do { _Pragma("unroll") for (int m = 0; m < 4; ++m) _Pragma("unroll") for (int k = 0; k < 2; ++k) dst[m][k] = *(const LAS bf16x8*)(lds + PG8_SA(b, h) + aoff + m * 2048 + k * 1024); } while (0)
#define PG8_LDB(dst, b, h) do { _Pragma("unroll") for (int n = 0; n < 2; ++n) _Pragma("unroll") for (int k = 0; k < 2; ++k) dst[n][k] = *(const LAS bf16x8*)(lds + PG8_SB(b, h) + boff + n * 2048 + k * 1024); } while (0)
#define PG8_MMA(ai, bj, At, Bt) do { __builtin_amdgcn_s_setprio(1); _Pragma("unroll") for (int m = 0; m < 4; ++m) _Pragma("unroll") for (int n = 0; n < 2; ++n) _Pragma("unroll") for (int k = 0; k < 2; ++k) \
        acc[ai][bj][m][n] = __builtin_amdgcn_mfma_f32_16x16x32_bf16(Bt[n][k], At[m][k], acc[ai][bj][m][n], 0, 0, 0); __builtin_amdgcn_s_setprio(0); } while (0)
#define PG8_WAIT_V(n) asm volatile("s_waitcnt vmcnt(" #n ")" ::: "memory")
#define PG8_WAIT_L(n) asm volatile("s_waitcnt lgkmcnt(" #n ")" ::: "memory")
#define PG8_BAR __builtin_amdgcn_s_barrier()
#define PG8_SCHED __builtin_amdgcn_sched_barrier(0)
    Unit cur, nxt; int ui = 0;
    if (!S.next(0, cur)) return;
    f32x4 acc[2][2][4][2];
#pragma unroll
    for (int a = 0; a < 2; ++a)
#pragma unroll
        for (int b = 0; b < 2; ++b)
#pragma unroll
            for (int m = 0; m < 4; ++m)
#pragma unroll
                for (int n = 0; n < 2; ++n) acc[a][b][m][n] = (f32x4){0.f, 0.f, 0.f, 0.f};
    bf16x8 At[4][2], B0[2][2], B1[2][2];
    const char* cA = S.a_ptr(cur); const char* cB = S.b_ptr(cur);
    if constexpr (SP2) {
        PG8_STAGE(PG8_SB(0, 0), cB, voffB); PG8_STAGE(PG8_SB(0, 1), cB + hstepB, voffB); PG8_STAGE(PG8_SA(0, 0), cA, voffA); PG8_STAGE(PG8_SA(0, 1), cA + hstepA, voffA);
        if (wr == 1) PG8_BAR;
        PG8_WAIT_V(2); PG8_BAR;
        PG8_STAGE(PG8_SB(1, 0), cB + kstep, voffB); PG8_STAGE(PG8_SA(1, 0), cA + kstep, voffA); PG8_STAGE(PG8_SB(1, 1), cB + hstepB + kstep, voffB);
        PG8_WAIT_V(6); PG8_BAR;
    } else {
    PG8_STAGE(PG8_SB(0, 0), cB, voffB); PG8_STAGE(PG8_SA(0, 0), cA, voffA); PG8_STAGE(PG8_SB(0, 1), cB + hstepB, voffB); PG8_STAGE(PG8_SA(0, 1), cA + hstepA, voffA);
    if (wr == 1) PG8_BAR;
    PG8_WAIT_V(4); PG8_BAR;
    PG8_STAGE(PG8_SB(1, 0), cB + kstep, voffB); PG8_STAGE(PG8_SA(1, 0), cA + kstep, voffA); PG8_STAGE(PG8_SB(1, 1), cB + hstepB + kstep, voffB);
    PG8_WAIT_V(6); PG8_BAR;
    }
    for (;;) {
        const bool has_next = S.next(ui + 1, nxt);
        const char* nA = has_next ? S.a_ptr(nxt) : cA; const char* nB = has_next ? S.b_ptr(nxt) : cB;
        for (int t = 0; t < nt; t += 2) {
            const bool last = (t == nt - 2);
            const char* a1 = cA + (size_t)(t + 1) * kstep;
            const char* a2 = last ? nA : cA + (size_t)(t + 2) * kstep; const char* b2 = last ? nB : cB + (size_t)(t + 2) * kstep;
            const char* a3 = a2 + kstep; const char* b3 = b2 + kstep;
            if constexpr (SP2) {
            PG8_LDB(B0, 0, 0); PG8_LDB(B1, 0, 1); PG8_SCHED; PG8_LDA(At, 0, 0); PG8_STAGE(PG8_SA(1, 1), a1 + hstepA, voffA);
            PG8_WAIT_V(8); PG8_WAIT_L(0); PG8_BAR; PG8_MMA(0, 0, At, B0); PG8_MMA(0, 1, At, B1); PG8_BAR; PG8_SCHED;
            PG8_LDA(At, 0, 1); PG8_STAGE(PG8_SB(0, 0), b2, voffB); PG8_STAGE(PG8_SB(0, 1), b2 + hstepB, voffB); PG8_STAGE(PG8_SA(0, 0), a2, voffA);
            PG8_WAIT_V(8); PG8_WAIT_L(0); PG8_BAR; PG8_MMA(1, 0, At, B0); PG8_MMA(1, 1, At, B1); PG8_BAR; PG8_SCHED;
            PG8_LDB(B0, 1, 0); PG8_LDB(B1, 1, 1); PG8_SCHED; PG8_LDA(At, 1, 0); PG8_STAGE(PG8_SA(0, 1), a2 + hstepA, voffA);
            PG8_WAIT_V(8); PG8_WAIT_L(0); PG8_BAR; PG8_MMA(0, 0, At, B0); PG8_MMA(0, 1, At, B1); PG8_BAR; PG8_SCHED;
            PG8_LDA(At, 1, 1); PG8_STAGE(PG8_SB(1, 0), b3, voffB); PG8_STAGE(PG8_SB(1, 1), b3 + hstepB, voffB); PG8_STAGE(PG8_SA(1, 0), a3, voffA);
            PG8_WAIT_V(8); PG8_WAIT_L(0); PG8_BAR; PG8_MMA(1, 0, At, B0); PG8_MMA(1, 1, At, B1); PG8_BAR; PG8_SCHED;
            } else {
            PG8_LDB(B0, 0, 0); PG8_SCHED; PG8_LDA(At, 0, 0); PG8_STAGE(PG8_SA(1, 1), a1 + hstepA, voffA);
            PG8_WAIT_L(8); PG8_BAR; PG8_WAIT_L(0); PG8_MMA(0, 0, At, B0); PG8_BAR; PG8_SCHED;
            PG8_LDB(B1, 0, 1); PG8_STAGE(PG8_SB(0, 0), b2, voffB);
            PG8_BAR; PG8_WAIT_L(0); PG8_MMA(0, 1, At, B1); PG8_BAR;
            PG8_LDA(At, 0, 1); PG8_STAGE(PG8_SA(0, 0), a2, voffA);
            PG8_BAR; PG8_WAIT_L(0); PG8_MMA(1, 0, At, B0); PG8_BAR; PG8_SCHED;
            PG8_STAGE(PG8_SB(0, 1), b2 + hstepB, voffB);
            PG8_WAIT_V(6); PG8_BAR; PG8_MMA(1, 1, At, B1); PG8_BAR;
            PG8_LDB(B0, 1, 0); PG8_SCHED; PG8_LDA(At, 1, 0); PG8_STAGE(PG8_SA(0, 1), a2 + hstepA, voffA);
            PG8_WAIT_L(8); PG8_BAR; PG8_WAIT_L(0); PG8_MMA(0, 0, At, B0); PG8_BAR; PG8_SCHED;
            PG8_LDB(B1, 1, 1); PG8_STAGE(PG8_SB(1, 0), b3, voffB);
            PG8_BAR; PG8_WAIT_L(0); PG8_MMA(0, 1, At, B1); PG8_BAR;
            PG8_LDA(At, 1, 1); PG8_STAGE(PG8_SA(1, 0), a3, voffA);
            PG8_BAR; PG8_WAIT_L(0); PG8_MMA(1, 0, At, B0); PG8_BAR; PG8_SCHED;
            PG8_STAGE(PG8_SB(1, 1), b3 + hstepB, voffB);
            PG8_WAIT_V(6); PG8_BAR; PG8_MMA(1, 1, At, B1); PG8_BAR;
            }
        }
        if constexpr (ALIGN_EPI) { if (wr == 0) PG8_BAR; }
        { const int l2 = ltid(wv) & 63; E(acc, cur, wr, wc, l2 & 15, l2 >> 4); }
        if (!has_next) break;
#pragma unroll
        for (int a = 0; a < 2; ++a)
#pragma unroll
            for (int b = 0; b < 2; ++b)
#pragma unroll
                for (int m = 0; m < 4; ++m)
#pragma unroll
                    for (int n = 0; n < 2; ++n) acc[a][b][m][n] = (f32x4){0.f, 0.f, 0.f, 0.f};
        cur = nxt; cA = nA; cB = nB; ++ui;
        if constexpr (ALIGN_EPI) { if (wr == 1) PG8_BAR; }
    }
    PG8_WAIT_V(0);
    if constexpr (!ALIGN_EPI) { if (wr == 0) PG8_BAR; }
    PG8_BAR;
#undef PG8_SA
#undef PG8_SB
#undef PG8_STAGE
#undef PG8_LDA
#undef PG8_LDB
#undef PG8_MMA
#undef PG8_WAIT_V
#undef PG8_WAIT_L
#undef PG8_BAR
#undef PG8_SCHED
}

typedef const f32x4 (&AccRef)[2][2][4][2];

struct EpiZ {
    static constexpr bool PERM = true; bf16_t* z; bf16_t* uc;
    __device__ __forceinline__ void operator()(AccRef acc, const Unit& u, int wr, int wc, int fr, int fq) const {
        const int row0 = u.pm * BM + wr * 64 + fr;
#pragma unroll
        for (int ai = 0; ai < 2; ++ai)
#pragma unroll
            for (int m = 0; m < 4; ++m) { const int r = row0 + ai * HALF + m * 16;
#pragma unroll
                for (int bj = 0; bj < 2; ++bj) { const f32x4 v0 = acc[ai][bj][m][0], v1 = acc[ai][bj][m][1];
                    u32x4 w; w.x = pk2(v0[0], v0[1]); w.y = pk2(v0[2], v0[3]); w.z = pk2(v1[0], v1[1]); w.w = pk2(v1[2], v1[3]);
                    const int c0 = u.pn * BM + bj * HALF + wc * 32 + 8 * fq;
                    if (u.pn == 4) { const int cc = c0 - C_SU, g = cc >> 4, c8 = cc & 15, b = r >> 12, t = r & 4095;
                        *(u32x4*)(uc + ((size_t)(g * 1024 + b * 64 + (t >> 6)) * 1280 + (t & 63) * 16 + c8)) = w; }
                    else { const int tb = r >> 6, i = r & 63; size_t off;
                        if (c0 < 1024) off = ZR_OFF + ((size_t)(tb * 4 + ((c0 >> 6) & 3)) * 64 + i) * 256 + (c0 >> 8) * 64 + (c0 & 63);
                        else if (c0 < C_GV) off = ZG_OFF + ((size_t)(tb * 4 + (((c0 - C_GQ) >> 6) & 3)) * 64 + i) * 384 + ((c0 - C_GQ) >> 8) * 64 + (c0 & 63);
                        else if (c0 < C_LR) { const int cc = c0 - C_GV, sec = cc >> 9, hh = (cc >> 7) & 3; off = ZG_OFF + ((size_t)(tb * 4 + hh) * 64 + i) * 384 + 128 + sec * 128 + (cc & 127); }
                        else off = ZL_OFF + (size_t)r * 16 + (c0 - C_LR);
                        if (c0 < C_LR + 16) *(u32x4*)(z + off) = w; } } }
    }
};
struct EpiXloc {
    static constexpr bool PERM = false; float* X;
    __device__ __forceinline__ void operator()(AccRef acc, const Unit& u, int wr, int wc, int fr, int fq) const {
        float* base = X + (size_t)u.bt * 1024 * 256; const int row0 = u.pm * BM + wr * 64 + fr, col0 = wc * 32 + 4 * fq;
#pragma unroll
        for (int ai = 0; ai < 2; ++ai)
#pragma unroll
            for (int m = 0; m < 4; ++m) { float* rowp = base + (size_t)(row0 + ai * HALF + m * 16) * 256 + col0;
#pragma unroll
                for (int bj = 0; bj < 2; ++bj)
#pragma unroll
                    for (int n = 0; n < 2; ++n) *(f32x4*)(rowp + bj * HALF + n * 16) = acc[ai][bj][m][n]; }
    }
};
struct EpiS5Y {
    static constexpr bool PERM = true; bf16_t* Y;
    __device__ __forceinline__ void operator()(AccRef acc, const Unit& u, int wr, int wc, int fr, int fq) const {
        const int row0 = u.pm * BM + wr * 64 + fr;
#pragma unroll
        for (int ai = 0; ai < 2; ++ai)
#pragma unroll
            for (int m = 0; m < 4; ++m) { const int r = row0 + ai * HALF + m * 16;
                const int b = r >> 6, n = r & 63;
#pragma unroll
                for (int bj = 0; bj < 2; ++bj) { const f32x4 v0 = acc[ai][bj][m][0], v1 = acc[ai][bj][m][1];
                    const f32x2 a = gelu_pk((f32x2){v0[0], v0[1]}), bb = gelu_pk((f32x2){v0[2], v0[3]}), c = gelu_pk((f32x2){v1[0], v1[1]}), d = gelu_pk((f32x2){v1[2], v1[3]});
                    u32x4 w; w.x = pk2(a.x, a.y); w.y = pk2(bb.x, bb.y); w.z = pk2(c.x, c.y); w.w = pk2(d.x, d.y);
                    const int c0 = u.pn * BM + bj * HALF + wc * 32 + 8 * fq, t = c0 >> 4, c8 = c0 & 15;
                    *(u32x4*)(Y + (size_t)(b * SEQ + n * 64 + t) * 256 + u.bt * 16 + c8) = w; } }
    }
};
template <int ACT  > struct EpiBf16 {
    static constexpr bool PERM = true; bf16_t* O; int ldc;
    __device__ __forceinline__ void operator()(AccRef acc, const Unit& u, int wr, int wc, int fr, int fq) const {
        const int row0 = u.pm * BM + wr * 64 + fr, col0 = u.pn * BM + wc * 32 + 8 * fq;
#pragma unroll
        for (int ai = 0; ai < 2; ++ai)
#pragma unroll
            for (int m = 0; m < 4; ++m) { bf16_t* rowp = O + (size_t)(row0 + ai * HALF + m * 16) * ldc + col0;
#pragma unroll
                for (int bj = 0; bj < 2; ++bj) { f32x4 v0 = acc[ai][bj][m][0], v1 = acc[ai][bj][m][1];
                    if (ACT == 1) {
#pragma unroll
                        for (int j = 0; j < 4; ++j) { const float a = __builtin_amdgcn_fmed3f(v0[j], 0.f, 3.0e38f), b = __builtin_amdgcn_fmed3f(v1[j], 0.f, 3.0e38f); v0[j] = a * a; v1[j] = b * b; } }
                    u32x4 w; w.x = pk2(v0[0], v0[1]); w.y = pk2(v0[2], v0[3]); w.z = pk2(v1[0], v1[1]); w.w = pk2(v1[2], v1[3]);
                    *(u32x4*)(rowp + bj * HALF) = w; } }
    }
};
struct EpiGLU {
    static constexpr bool PERM = true; bf16_t* O;
    __device__ __forceinline__ void operator()(AccRef acc, const Unit& u, int wr, int wc, int fr, int fq) const {
        const int row0 = u.pm * BM + wr * 64 + fr, col0 = u.pn * HALF + wc * 32 + 8 * fq;
#pragma unroll
        for (int ai = 0; ai < 2; ++ai)
#pragma unroll
            for (int m = 0; m < 4; ++m) { bf16_t* rowp = O + (size_t)(row0 + ai * HALF + m * 16) * DM + col0;
                f32x4 v0 = acc[ai][0][m][0], v1 = acc[ai][0][m][1]; const f32x4 g0 = acc[ai][1][m][0], g1 = acc[ai][1][m][1];
#pragma unroll
                for (int j = 0; j < 4; ++j) { v0[j] *= sigmoidf_(g0[j]); v1[j] *= sigmoidf_(g1[j]); }
                u32x4 w; w.x = pk2(v0[0], v0[1]); w.y = pk2(v0[2], v0[3]); w.z = pk2(v1[0], v1[1]); w.w = pk2(v1[2], v1[3]);
                *(u32x4*)rowp = w; }
    }
};
struct EpiMerge {
    static constexpr bool PERM = true; const bf16_t* br; bf16_t* mg; const float* bias;
    __device__ __forceinline__ void operator()(AccRef acc, const Unit& u, int wr, int wc, int fr, int fq) const {
        const int seg = u.pn >> 2, j = u.pn & 3;
        const int row0 = u.pm * BM + wr * 64 + fr, ch0 = j * BM + wc * 32 + 8 * fq;
        const bf16_t* brs = br + (size_t)seg * NTOK * DM;
        f32x4 bv[2][2];
#pragma unroll
        for (int bj = 0; bj < 2; ++bj)
#pragma unroll
            for (int n = 0; n < 2; ++n) bv[bj][n] = *(const f32x4*)(bias + seg * DM + ch0 + bj * HALF + 4 * n);
#pragma unroll
        for (int ai = 0; ai < 2; ++ai)
#pragma unroll
            for (int m = 0; m < 4; ++m) { const size_t ro = (size_t)(row0 + ai * HALF + m * 16) * DM + ch0;
#pragma unroll
                for (int bj = 0; bj < 2; ++bj) { const f32x4 a0 = acc[ai][bj][m][0] + bv[bj][0], a1 = acc[ai][bj][m][1] + bv[bj][1];
                    const u32x4 bw = *(const u32x4*)(brs + ro + bj * HALF);
                    float r[8];
                    r[0] = bf2f(bw.x & 0xffffu) * sigmoidf_(a0[0]); r[1] = bf2f(bw.x >> 16) * sigmoidf_(a0[1]); r[2] = bf2f(bw.y & 0xffffu) * sigmoidf_(a0[2]); r[3] = bf2f(bw.y >> 16) * sigmoidf_(a0[3]);
                    r[4] = bf2f(bw.z & 0xffffu) * sigmoidf_(a1[0]); r[5] = bf2f(bw.z >> 16) * sigmoidf_(a1[1]); r[6] = bf2f(bw.w & 0xffffu) * sigmoidf_(a1[2]); r[7] = bf2f(bw.w >> 16) * sigmoidf_(a1[3]);
                    if (seg != 0) { const u32x4 mw = *(const u32x4*)(mg + ro + bj * HALF);
                        r[0] += bf2f(mw.x & 0xffffu); r[1] += bf2f(mw.x >> 16); r[2] += bf2f(mw.y & 0xffffu); r[3] += bf2f(mw.y >> 16);
                        r[4] += bf2f(mw.z & 0xffffu); r[5] += bf2f(mw.z >> 16); r[6] += bf2f(mw.w & 0xffffu); r[7] += bf2f(mw.w >> 16); }
                    u32x4 w; w.x = pk2(r[0], r[1]); w.y = pk2(r[2], r[3]); w.z = pk2(r[4], r[5]); w.w = pk2(r[6], r[7]);
                    *(u32x4*)(mg + ro + bj * HALF) = w; } }
    }
};
struct EpiRes {
    static constexpr bool PERM = false; static constexpr int PMODE = 0; const float* Xin; float* X;
    __device__ __forceinline__ void operator()(AccRef acc, const Unit& u, int wr, int wc, int fr, int fq) const {
        const int row0 = u.pm * BM + wr * 64 + fr, col0 = u.pn * BM + wc * 32 + 4 * fq;
#pragma unroll
        for (int ai = 0; ai < 2; ++ai)
#pragma unroll
            for (int m = 0; m < 4; ++m) { const size_t ro = (size_t)(row0 + ai * HALF + m * 16) * DM + col0;
#pragma unroll
                for (int bj = 0; bj < 2; ++bj)
#pragma unroll
                    for (int n = 0; n < 2; ++n) { *(f32x4*)(X + ro + bj * HALF + n * 16) = *(const f32x4*)(Xin + ro + bj * HALF + n * 16) + acc[ai][bj][m][n]; } }
    }
};
}

__device__ __forceinline__ float wave_sum(float v, int lane) {
#pragma unroll
    for (int o = 1; o < 64; o <<= 1) v += shx(v, o, lane);
    return v;
}
__device__ __forceinline__ void rmsnorm_phase(const float* xin, float* xcopy, const float* g, bf16_t* h, const int wv) {
    const int tid = ltid(wv), lane = tid & 63, wave = tid >> 6, step = lgdim() * 8;
    f32x4 gv[4];
#pragma unroll
    for (int i = 0; i < 4; ++i) gv[i] = *(const f32x4*)(g + i * 256 + lane * 4);
    int row = lbid() * 8 + wave; f32x4 v[4], nv[4];
    if (row < NTOK) {
#pragma unroll
        for (int i = 0; i < 4; ++i) v[i] = *(const f32x4*)(xin + (size_t)row * DM + i * 256 + lane * 4); }
    for (; row < NTOK; row += step) {
        if (row + step < NTOK) {
#pragma unroll
            for (int i = 0; i < 4; ++i) nv[i] = *(const f32x4*)(xin + (size_t)(row + step) * DM + i * 256 + lane * 4); }
        float s = 0.f;
#pragma unroll
        for (int i = 0; i < 4; ++i) s += v[i][0] * v[i][0] + v[i][1] * v[i][1] + v[i][2] * v[i][2] + v[i][3] * v[i][3];
        s = wave_sum(s, lane); const float rs = __builtin_amdgcn_rsqf(s * (1.0f / DM) + EPS);
#pragma unroll
        for (int i = 0; i < 4; ++i) { u32x2 w; w.x = pk2(v[i][0] * rs * gv[i][0], v[i][1] * rs * gv[i][1]); w.y = pk2(v[i][2] * rs * gv[i][2], v[i][3] * rs * gv[i][3]);
            *(u32x2*)(h + (size_t)row * DM + i * 256 + lane * 4) = w;
            if (xcopy) *(f32x4*)(xcopy + (size_t)row * DM + i * 256 + lane * 4) = v[i]; }
#pragma unroll
        for (int i = 0; i < 4; ++i) v[i] = nv[i];
    }
}
__device__ __forceinline__ void final_norm_phase(float* x, const float* g, const int wv) {
    const int tid = ltid(wv), lane = tid & 63, wave = tid >> 6;
    f32x4 gv[4];
#pragma unroll
    for (int i = 0; i < 4; ++i) gv[i] = *(const f32x4*)(g + i * 256 + lane * 4);
    for (int row = lbid() * 8 + wave; row < NTOK; row += lgdim() * 8) {
        float* xr = x + (size_t)row * DM; f32x4 v[4]; float s = 0.f;
#pragma unroll
        for (int i = 0; i < 4; ++i) { v[i] = *(const f32x4*)(xr + i * 256 + lane * 4); s += v[i][0] * v[i][0] + v[i][1] * v[i][1] + v[i][2] * v[i][2] + v[i][3] * v[i][3]; }
        s = wave_sum(s, lane); const float rs = __builtin_amdgcn_rsqf(s * (1.0f / DM) + EPS);
#pragma unroll
        for (int i = 0; i < 4; ++i) *(f32x4*)(xr + i * 256 + lane * 4) = v[i] * rs * gv[i];
    }
}

template <class Map>
__device__ __forceinline__ void conv_issue(const float* src, int Nsrc, int ntn, int t, int tid, Map map, float (&r)[8]) {
    const int tn = t % ntn, tk = t / ntn;
#pragma unroll
    for (int it = 0; it < 8; ++it) { const int idx = it * 512 + tid, kk = idx >> 6, nn = idx & 63; const int col = map(tn * 64 + nn);
        r[it] = col >= 0 ? src[(size_t)(tk * 64 + kk) * Nsrc + col] : 0.f; }
}
template <class Map>
__device__ __forceinline__ void conv_T(LAS unsigned char* lds, const float* src, int K, int Nsrc, bf16_t* dst, int Ndst, Map map, const int wv) {
    LAS float* tile = (LAS float*)lds;
    const int tid = ltid(wv), ntn = Ndst / 64, ntiles = ntn * (K / 64), G = lgdim();
    float cur[8], nx1[8], nx2[8];
    int t = lbid();
    if (t < ntiles) conv_issue(src, Nsrc, ntn, t, tid, map, cur);
    if (t + G < ntiles) conv_issue(src, Nsrc, ntn, t + G, tid, map, nx1);
    for (; t < ntiles; t += G) {
        if (t + 2 * G < ntiles) conv_issue(src, Nsrc, ntn, t + 2 * G, tid, map, nx2);
        const int tn = t % ntn, tk = t / ntn;
#pragma unroll
        for (int it = 0; it < 8; ++it) { const int idx = it * 512 + tid, kk = idx >> 6, nn = idx & 63; tile[nn * 65 + kk] = cur[it]; }
        asm volatile("s_waitcnt lgkmcnt(0)\n\ts_barrier" ::: "memory");
        { const int nn = tid >> 3, sg = tid & 7; LAS const float* tp = tile + nn * 65 + sg * 8;
          u32x4 w; w.x = pk2(tp[0], tp[1]); w.y = pk2(tp[2], tp[3]); w.z = pk2(tp[4], tp[5]); w.w = pk2(tp[6], tp[7]);
          *(u32x4*)(dst + (size_t)(tn * 64 + nn) * K + tk * 64 + sg * 8) = w; }
        asm volatile("s_waitcnt lgkmcnt(0)\n\ts_barrier" ::: "memory");
#pragma unroll
        for (int it = 0; it < 8; ++it) { cur[it] = nx1[it]; nx1[it] = nx2[it]; }
    }
}
struct MapId { __device__ __forceinline__ int operator()(int n) const { return n; } };
struct MapZ { __device__ __forceinline__ int operator()(int n) const { return n < 2304 ? n : (n < 2816 ? n + 16 : (n < 2832 ? n - 512 : -1)); } };
struct MapGLU { __device__ __forceinline__ int operator()(int n) const { const int pn = n >> 8, bj = (n >> 7) & 1, i = n & 127; return bj * 1024 + pn * 128 + i; } };

__device__ __forceinline__ void s5_prep(LAS unsigned char* lds, const S5In p, int l, int unit, bf16_t* T1t, bf16_t* T2t, const int wv) {
    const int tid = ltid(wv), g = unit >> 4, c = unit & 15;
    LAS f32x2* Lpow = (LAS f32x2*)lds;
    LAS f32x2* Bb = (LAS f32x2*)(lds + 66560);
    LAS f32x2* Wm = (LAS f32x2*)(lds + 66560 + 16384);
    LAS float* Kt = (LAS float*)(lds + 66560 + 32768);
    const float* lam_re = p.lam_re + (size_t)l * 2048; const float* lam_im = p.lam_im + (size_t)l * 2048; const float* log_dt = p.log_dt + (size_t)l * 32;
    const float* b_re = p.b_re + (size_t)l * 32768; const float* b_im = p.b_im + (size_t)l * 32768;
    const float* c_re = p.c_re + (size_t)l * 32768; const float* c_im = p.c_im + (size_t)l * 32768;
    {
        const int dp = tid >> 2, dir = dp >> 6, pp = dp & 63, q4 = tid & 3;
        const float lr = lam_re[(dir * 16 + g) * 64 + pp], li = lam_im[(dir * 16 + g) * 64 + pp], dt = __expf(log_dt[dir * 16 + g]);
        for (int tau = q4; tau <= 64; tau += 4) { const float mag = __expf(lr * dt * (float)tau); float s, cs; sincos_turns((double)li * (double)dt * (double)tau * INV2PI, s, cs);
            Lpow[(dir * 64 + pp) * 65 + tau] = (f32x2){mag * cs, mag * s}; }
        const float mag1 = __expf(lr * dt); float s1, c1; sincos_turns((double)li * (double)dt * INV2PI, s1, c1);
        const float nr = mag1 * c1 - 1.0f, ni = mag1 * s1, den = 1.0f / (lr * lr + li * li);
        const float rr = (nr * lr + ni * li) * den, ri = (ni * lr - nr * li) * den;
#pragma unroll
        for (int e = 0; e < 4; ++e) { const int cp = q4 * 4 + e; const float br = b_re[((dir * 16 + g) * 64 + pp) * 16 + cp], bi = b_im[((dir * 16 + g) * 64 + pp) * 16 + cp];
            Bb[(dir * 64 + pp) * 16 + cp] = (f32x2){rr * br - ri * bi, rr * bi + ri * br}; }
    }
    __syncthreads();
#pragma unroll
    for (int k = 0; k < 4; ++k) { const int idx = tid + 512 * k, dir = idx >> 10, pp = (idx >> 4) & 63;
        const float cr = c_re[((dir * 16 + g) * 16 + c) * 64 + pp], ci = c_im[((dir * 16 + g) * 16 + c) * 64 + pp]; const f32x2 b = Bb[idx];
        Wm[idx] = (f32x2){cr * b.x - ci * b.y, cr * b.y + ci * b.x}; }
    __syncthreads();
#pragma unroll
    for (int k = 0; k < 4; ++k) { const int idx = tid + 512 * k, dir = idx >> 10, tau = (idx >> 4) & 63, cp = idx & 15; float s = 0.f;
        for (int pp = 0; pp < 64; ++pp) { const f32x2 w = Wm[(dir * 64 + pp) * 16 + cp], L = Lpow[(dir * 64 + pp) * 65 + tau]; s += w.x * L.x - w.y * L.y; }
        Kt[idx] = s; }
    __syncthreads();
    const float Dv = p.d[l * 256 + g * 16 + c];
    for (int k = 0; k < 20; ++k) { const int seg = tid + 512 * k, t = seg / 160, sk = seg - t * 160; float v[8];
        if (sk < 128) { const int s = sk >> 1, c0 = (sk & 1) * 8;
#pragma unroll
            for (int e = 0; e < 8; ++e) { const int cp = c0 + e; float a = 0.f; if (t >= s) a += Kt[(t - s) * 16 + cp]; if (s >= t) a += Kt[1024 + (s - t) * 16 + cp]; if (s == t && cp == c) a += Dv; v[e] = a; } }
        else { const int kk = (sk - 128) * 8, which = kk >> 6, p0 = kk & 63, dir = which >> 1, im = which & 1, tau = dir == 0 ? t + 1 : 64 - t;
#pragma unroll
            for (int e = 0; e < 8; ++e) { const int pp = p0 + e; const float cr = c_re[((dir * 16 + g) * 16 + c) * 64 + pp], ci = c_im[((dir * 16 + g) * 16 + c) * 64 + pp]; const f32x2 L = Lpow[(dir * 64 + pp) * 65 + tau];
                v[e] = im ? -(cr * L.y + ci * L.x) : (cr * L.x - ci * L.y); } }
        u32x4 w; w.x = pk2(v[0], v[1]); w.y = pk2(v[2], v[3]); w.z = pk2(v[4], v[5]); w.w = pk2(v[6], v[7]);
        *(u32x4*)(T2t + ((size_t)g * 1024 + t * 16 + c) * 1280 + sk * 8) = w; }
#pragma unroll
    for (int k = 0; k < 4; ++k) { const int seg = tid + 512 * k, rr = seg >> 7, sk = seg & 127, dir = rr >> 3, ri = (rr >> 2) & 1, pp = 4 * c + (rr & 3), s = sk >> 1, c0 = (sk & 1) * 8;
        const f32x2 L = Lpow[(dir * 64 + pp) * 65 + (dir == 0 ? 63 - s : s)]; float v[8];
#pragma unroll
        for (int e = 0; e < 8; ++e) { const f32x2 b = Bb[(dir * 64 + pp) * 16 + c0 + e]; v[e] = ri ? (L.x * b.y + L.y * b.x) : (L.x * b.x - L.y * b.y); }
        u32x4 w; w.x = pk2(v[0], v[1]); w.y = pk2(v[2], v[3]); w.z = pk2(v[4], v[5]); w.w = pk2(v[6], v[7]);
        *(u32x4*)(T1t + ((size_t)g * 256 + dir * 128 + ri * 64 + pp) * 1024 + sk * 8) = w; }
    __syncthreads();
}
constexpr int L_BF = 0, L_BB = 16640, L_QIN = 33280, L_KIN = 42496, L_P = 51712, L_VT = 60928, L_ST = 79360, L_LR = 97792  , L_WG = 102912  ,
              L_BG = 113152  , L_TOT = 113664, L_NG = 117760  ;
constexpr int GS = 40;
constexpr int RS = 72;
template <int DV, bool GATED> struct Bla {
    const bf16_t* z; const bf16_t* zl; const float* wg; const float* bg; bf16_t* st; float* dec; const float* ng; bf16_t* out; int ldo;
};
__device__ __forceinline__ void lds_barrier() { asm volatile("s_waitcnt lgkmcnt(0)\n\ts_barrier" ::: "memory"); }
__device__ __forceinline__ bf16x8 frag(LAS const bf16_t* base, int row0, int kb, int lane) { return *(LAS const bf16x8*)(base + (row0 + (lane & 15)) * RS + kb * 32 + (lane >> 4) * 8); }
__device__ __forceinline__ void unpack4(u32x2 w, float* o) { o[0] = bf2f(w.x & 0xffffu); o[1] = bf2f(w.x >> 16); o[2] = bf2f(w.y & 0xffffu); o[3] = bf2f(w.y >> 16); }

template <int DV, bool GATED, bool S2> struct BlaRegs { u32x2 k0, k1, q0, q1; u32x4 lrf; u32x4 v[DV / 64]; u32x4 st[2][DV / 64]; u32x4 og[DV / 64]; };
template <int DV, bool GATED, bool S2>
__device__ __forceinline__ void bla_issue(const Bla<DV, GATED>& P, int unit, int tid, BlaRegs<DV, GATED, S2>& R) {
    const int b = unit >> 8, n = (unit >> 2) & 63, h = unit & 3, j = tid >> 3, sg = tid & 7; const int tok0 = b * SEQ + n * 64;
    constexpr int ROW = 128 + 2 * DV;
    const bf16_t* zr = P.z + ((size_t)((b * 64 + n) * 4 + h) * 64 + j) * ROW;
    R.k0 = *(const u32x2*)(zr + 64 + sg * 4); R.k1 = *(const u32x2*)(zr + 64 + 32 + sg * 4);
    if (S2) { R.q0 = __builtin_nontemporal_load((const u32x2*)(zr + sg * 4)); R.q1 = __builtin_nontemporal_load((const u32x2*)(zr + 32 + sg * 4)); }
    constexpr int NV = DV / 8;
#pragma unroll
    for (int q = 0; q < NV / 8; ++q) R.v[q] = *(const u32x4*)(zr + 128 + sg * NV + q * 8);
    if (GATED) { const int lane = tid & 63, jt = (tid >> 6) & 3;
        R.lrf = (lane < 32) ? *(const u32x4*)(P.zl + (size_t)(tok0 + jt * 16 + (lane & 15)) * 16 + (lane >> 4) * 8) : (u32x4){0u, 0u, 0u, 0u}; }
    if (S2) {
#pragma unroll
        for (int dir = 0; dir < 2; ++dir) { const bf16_t* stb = P.st + ((size_t)((b * 4 + h) * 2 + dir) * 64 + n) * (DV * 64);
#pragma unroll
            for (int q = 0; q < DV / 64; ++q) { const int sgi = tid + 512 * q, e = sgi >> 3, d8 = (sgi & 7) * 8; R.st[dir][q] = __builtin_nontemporal_load((const u32x4*)(stb + e * 64 + d8)); } }
#pragma unroll
        for (int q = 0; q < NV / 8; ++q) R.og[q] = __builtin_nontemporal_load((const u32x4*)(zr + 128 + DV + sg * NV + q * 8));
    }
}
template <int DV, bool GATED>
__device__ __forceinline__ void bla_head_consts(LAS unsigned char* lds, const Bla<DV, GATED>& P, int h, int tid) {
    LAS bf16_t* wgt = (LAS bf16_t*)(lds + L_WG); LAS bf16_t* lra = (LAS bf16_t*)(lds + L_LR); LAS float* bgs = (LAS float*)(lds + L_BG); LAS float* ngs = (LAS float*)(lds + L_NG);
    if (GATED) {
#pragma unroll
        for (int k = 0; k < 4; ++k) { const int idx = tid + 512 * k, dir = idx >> 10, r = (idx >> 6) & 15, d = idx & 63; wgt[(dir * 64 + d) * GS + r] = (bf16_t)f2bf(P.wg[(dir * 16 + r) * 256 + h * 64 + d]); }
#pragma unroll
        for (int k = 0; k < 4; ++k) { const int idx = tid + 512 * k, c = idx >> 4, r = 16 + (idx & 15); wgt[c * GS + r] = 0; }
        for (int idx = tid; idx < 1024; idx += 512) lra[(idx >> 4) * GS + 16 + (idx & 15)] = 0;
        if (tid < 128) bgs[tid] = P.bg[(tid >> 6) * 256 + h * 64 + (tid & 63)];
    }
    if (tid < DV) ngs[tid] = P.ng[h * DV + tid];
    lds_barrier();
}

template <int DV, bool GATED, bool S2>
__device__ __forceinline__ void bla_front(LAS unsigned char* lds, const BlaRegs<DV, GATED, S2>& R, int n, int h, int tid, float (&klo)[4], float (&khi)[4], float (&qlo)[4], float (&qhi)[4]) {
    const int j = tid >> 3, sg = tid & 7;
    LAS float* bf = (LAS float*)(lds + L_BF); LAS float* bb = (LAS float*)(lds + L_BB); LAS bf16_t* vT = (LAS bf16_t*)(lds + L_VT);
    unpack4(R.k0, klo); unpack4(R.k1, khi);
    if (S2) { unpack4(R.q0, qlo); unpack4(R.q1, qhi);
#pragma unroll
        for (int e = 0; e < 4; ++e) { qlo[e] *= 0.125f; qhi[e] *= 0.125f; } }
    if (!GATED) {
        const float pos = (float)(n * 64 + j);
#pragma unroll
        for (int e = 0; e < 4; ++e) { const int i = sg * 4 + e; const float inv = __builtin_amdgcn_exp2f(-(float)i * (13.287712379549449f / 32.0f)); float s, c; sincos_turns((double)pos * (double)inv * INV2PI, s, c);
            const float a = klo[e], bq = khi[e]; klo[e] = a * c - bq * s; khi[e] = a * s + bq * c;
            if (S2) { const float a2 = qlo[e], b2 = qhi[e]; qlo[e] = a2 * c - b2 * s; qhi[e] = a2 * s + b2 * c; } }
    }
    if (S2) {
        constexpr int NV = DV / 8;
#pragma unroll
        for (int q = 0; q < NV / 8; ++q) { const u32x4 w = R.v[q]; const int e0 = sg * NV + q * 8;
            vT[(e0 + 0) * RS + j] = (bf16_t)(w.x & 0xffffu); vT[(e0 + 1) * RS + j] = (bf16_t)(w.x >> 16); vT[(e0 + 2) * RS + j] = (bf16_t)(w.y & 0xffffu); vT[(e0 + 3) * RS + j] = (bf16_t)(w.y >> 16);
            vT[(e0 + 4) * RS + j] = (bf16_t)(w.z & 0xffffu); vT[(e0 + 5) * RS + j] = (bf16_t)(w.z >> 16); vT[(e0 + 6) * RS + j] = (bf16_t)(w.w & 0xffffu); vT[(e0 + 7) * RS + j] = (bf16_t)(w.w >> 16); }
    } else {
        constexpr int NV = DV / 8, RSV = DV + 16;
#pragma unroll
        for (int q = 0; q < NV / 8; ++q) *(LAS u32x4*)(vT + j * RSV + sg * NV + q * 8) = R.v[q];
    }
    if (GATED) {
        LAS bf16_t* lra = (LAS bf16_t*)(lds + L_LR); LAS const bf16_t* wgt = (LAS const bf16_t*)(lds + L_WG); LAS const float* bgs = (LAS const float*)(lds + L_BG); LAS float* tot = (LAS float*)(lds + L_TOT);
        {
            const int lane = tid & 63, wave = tid >> 6; (void)lra;
            bf16x8 a; { const u32x4 w = R.lrf; a = __builtin_bit_cast(bf16x8, w); }
#pragma unroll
            for (int k = 0; k < 4; ++k) { const int t = wave + 8 * k, jt = t & 3, ct = t >> 2;
                const bf16x8 bq = *(LAS const bf16x8*)(wgt + (ct * 16 + (lane & 15)) * GS + (lane >> 4) * 8);
                f32x4 acc = {0.f, 0.f, 0.f, 0.f}; acc = __builtin_amdgcn_mfma_f32_16x16x32_bf16(a, bq, acc, 0, 0, 0);
                const int c = ct * 16 + (lane & 15); const float bias = bgs[c]; LAS float* dst = (c < 64 ? bf : bb) + (c & 63);
#pragma unroll
                for (int r = 0; r < 4; ++r) { const float x = acc[r] + bias; dst[(jt * 16 + (lane >> 4) * 4 + r) * 65] = (fminf(x, 0.f) - __logf(1.0f + __expf(-fabsf(x)))) * 0.0625f; } }
        }
        lds_barrier();
        {
            const int d = tid & 63, s8 = tid >> 6; float run = 0.f;
#pragma unroll
            for (int jj = 0; jj < 8; ++jj) { run += bf[(s8 * 8 + jj) * 65 + d]; bf[(s8 * 8 + jj) * 65 + d] = run; }
            tot[s8 * 64 + d] = run; run = 0.f;
#pragma unroll
            for (int jj = 7; jj >= 0; --jj) { run += bb[(s8 * 8 + jj) * 65 + d]; bb[(s8 * 8 + jj) * 65 + d] = run; }
            tot[512 + s8 * 64 + d] = run;
            lds_barrier();
            float of = 0.f, ob = 0.f;
#pragma unroll
            for (int s = 0; s < 8; ++s) { if (s < s8) of += tot[s * 64 + d]; if (s > s8) ob += tot[512 + s * 64 + d]; }
#pragma unroll
            for (int jj = 0; jj < 8; ++jj) { bf[(s8 * 8 + jj) * 65 + d] += of; bb[(s8 * 8 + jj) * 65 + d] += ob; }
        }
        lds_barrier();
    }
}

template <int DV, bool GATED>
__device__ __forceinline__ void bla_stage1(LAS unsigned char* lds, const Bla<DV, GATED>& P, int unit, const BlaRegs<DV, GATED, false>& R, int tid) {
    const int b = unit >> 8, n = (unit >> 2) & 63, h = unit & 3;
    const int lane = tid & 63, wave = tid >> 6, j = tid >> 3, sg = tid & 7;
    LAS float* bf = (LAS float*)(lds + L_BF); LAS float* bb = (LAS float*)(lds + L_BB); LAS bf16_t* vT = (LAS bf16_t*)(lds + L_VT);
    float klo[4], khi[4], qlo[4], qhi[4];
    bla_front<DV, GATED, false>(lds, R, n, h, tid, klo, khi, qlo, qhi);
    const float lgam = __logf(1.0f - __builtin_amdgcn_exp2f(-5.0f - (float)h)), cf = __expf((float)(63 - j) * lgam), cb = __expf((float)j * lgam);
    constexpr int KS = 80;
    LAS bf16_t* ksf = (LAS bf16_t*)(lds + L_QIN); LAS bf16_t* ksb = (LAS bf16_t*)(lds + L_QIN + 10240);
#pragma unroll
    for (int half = 0; half < 2; ++half) { float vf[4], vb[4];
#pragma unroll
        for (int e = 0; e < 4; ++e) { const int d = half * 32 + sg * 4 + e; const float kv = half ? khi[e] : klo[e];
            vf[e] = kv * (GATED ? __expf(bf[63 * 65 + d] - bf[j * 65 + d]) : cf); vb[e] = kv * (GATED ? __expf(bb[d] - bb[j * 65 + d]) : cb); }
        u32x2 wf, wb; wf.x = pk2(vf[0], vf[1]); wf.y = pk2(vf[2], vf[3]); wb.x = pk2(vb[0], vb[1]); wb.y = pk2(vb[2], vb[3]);
        *(LAS u32x2*)(ksf + j * KS + half * 32 + sg * 4) = wf; *(LAS u32x2*)(ksb + j * KS + half * 32 + sg * 4) = wb; }
    if (GATED && tid < 128) { const int dir = tid >> 6, d = tid & 63; P.dec[((size_t)((b * 4 + h) * 2 + dir) * 64 + n) * 64 + d] = __expf(dir ? bb[d] : bf[63 * 65 + d]); }
    lds_barrier();
    constexpr int NT = DV / 32, RSV = DV + 16;
    {
        const int g = lane >> 4, q = (lane & 15) >> 2, p = lane & 3, dt4 = wave & 3;
        const unsigned vaddr = (unsigned)(unsigned long long)(vT) + (unsigned)(((8 * g + q) * RSV + (wave >> 2) * 16 + 4 * p) * 2);
        const unsigned aaddr_f = (unsigned)(unsigned long long)(ksf) + (unsigned)(((8 * g + q) * KS + dt4 * 16 + 4 * p) * 2), aaddr_b = aaddr_f + 10240u;
        u32x2 bq[NT][2][2], af[2][2], ab[2][2];
        if constexpr (DV == 128) { asm volatile("ds_read_b64_tr_b16 %0, %20 offset:0\n\t" "ds_read_b64_tr_b16 %1, %20 offset:1152\n\t" "ds_read_b64_tr_b16 %2, %20 offset:9216\n\t" "ds_read_b64_tr_b16 %3, %20 offset:10368\n\t" "ds_read_b64_tr_b16 %4, %20 offset:64\n\t" "ds_read_b64_tr_b16 %5, %20 offset:1216\n\t" "ds_read_b64_tr_b16 %6, %20 offset:9280\n\t" "ds_read_b64_tr_b16 %7, %20 offset:10432\n\t" "ds_read_b64_tr_b16 %8, %20 offset:128\n\t" "ds_read_b64_tr_b16 %9, %20 offset:1280\n\t" "ds_read_b64_tr_b16 %10, %20 offset:9344\n\t" "ds_read_b64_tr_b16 %11, %20 offset:10496\n\t" "ds_read_b64_tr_b16 %12, %20 offset:192\n\t" "ds_read_b64_tr_b16 %13, %20 offset:1344\n\t" "ds_read_b64_tr_b16 %14, %20 offset:9408\n\t" "ds_read_b64_tr_b16 %15, %20 offset:10560\n\t" "ds_read_b64_tr_b16 %16, %21 offset:0\n\t" "ds_read_b64_tr_b16 %17, %21 offset:640\n\t" "ds_read_b64_tr_b16 %18, %21 offset:5120\n\t" "ds_read_b64_tr_b16 %19, %21 offset:5760\n\t" "s_waitcnt lgkmcnt(0)" : "=&v"(bq[0][0][0]), "=&v"(bq[0][0][1]), "=&v"(bq[0][1][0]), "=&v"(bq[0][1][1]), "=&v"(bq[1][0][0]), "=&v"(bq[1][0][1]), "=&v"(bq[1][1][0]), "=&v"(bq[1][1][1]), "=&v"(bq[2][0][0]), "=&v"(bq[2][0][1]), "=&v"(bq[2][1][0]), "=&v"(bq[2][1][1]), "=&v"(bq[3][0][0]), "=&v"(bq[3][0][1]), "=&v"(bq[3][1][0]), "=&v"(bq[3][1][1]), "=&v"(af[0][0]), "=&v"(af[0][1]), "=&v"(af[1][0]), "=&v"(af[1][1]) : "v"(vaddr), "v"(aaddr_f) : "memory");
            asm volatile("ds_read_b64_tr_b16 %0, %4 offset:0\n\t" "ds_read_b64_tr_b16 %1, %4 offset:640\n\t" "ds_read_b64_tr_b16 %2, %4 offset:5120\n\t" "ds_read_b64_tr_b16 %3, %4 offset:5760\n\t" "s_waitcnt lgkmcnt(0)" : "=&v"(ab[0][0]), "=&v"(ab[0][1]), "=&v"(ab[1][0]), "=&v"(ab[1][1]) : "v"(aaddr_b) : "memory"); }
        else { asm volatile("ds_read_b64_tr_b16 %0, %12 offset:0\n\t" "ds_read_b64_tr_b16 %1, %12 offset:640\n\t" "ds_read_b64_tr_b16 %2, %12 offset:5120\n\t" "ds_read_b64_tr_b16 %3, %12 offset:5760\n\t" "ds_read_b64_tr_b16 %4, %12 offset:64\n\t" "ds_read_b64_tr_b16 %5, %12 offset:704\n\t" "ds_read_b64_tr_b16 %6, %12 offset:5184\n\t" "ds_read_b64_tr_b16 %7, %12 offset:5824\n\t" "ds_read_b64_tr_b16 %8, %13 offset:0\n\t" "ds_read_b64_tr_b16 %9, %13 offset:640\n\t" "ds_read_b64_tr_b16 %10, %13 offset:5120\n\t" "ds_read_b64_tr_b16 %11, %13 offset:5760\n\t" "s_waitcnt lgkmcnt(0)" : "=&v"(bq[0][0][0]), "=&v"(bq[0][0][1]), "=&v"(bq[0][1][0]), "=&v"(bq[0][1][1]), "=&v"(bq[1][0][0]), "=&v"(bq[1][0][1]), "=&v"(bq[1][1][0]), "=&v"(bq[1][1][1]), "=&v"(af[0][0]), "=&v"(af[0][1]), "=&v"(af[1][0]), "=&v"(af[1][1]) : "v"(vaddr), "v"(aaddr_f) : "memory");
            asm volatile("ds_read_b64_tr_b16 %0, %4 offset:0\n\t" "ds_read_b64_tr_b16 %1, %4 offset:640\n\t" "ds_read_b64_tr_b16 %2, %4 offset:5120\n\t" "ds_read_b64_tr_b16 %3, %4 offset:5760\n\t" "s_waitcnt lgkmcnt(0)" : "=&v"(ab[0][0]), "=&v"(ab[0][1]), "=&v"(ab[1][0]), "=&v"(ab[1][1]) : "v"(aaddr_b) : "memory"); }
#pragma unroll
        for (int dir = 0; dir < 2; ++dir) {
            bf16_t* stb = P.st + ((size_t)((b * 4 + h) * 2 + dir) * 64 + n) * (DV * 64);
#pragma unroll
            for (int k = 0; k < NT; ++k) { const int et = (wave >> 2) + 2 * k; f32x4 acc = {0.f, 0.f, 0.f, 0.f};
#pragma unroll
                for (int kb = 0; kb < 2; ++kb) { const u32x2 a0 = dir ? ab[kb][0] : af[kb][0], a1 = dir ? ab[kb][1] : af[kb][1];
                    const u32x4 aw = {a0.x, a0.y, a1.x, a1.y}, bw = {bq[k][kb][0].x, bq[k][kb][0].y, bq[k][kb][1].x, bq[k][kb][1].y};
                    acc = __builtin_amdgcn_mfma_f32_16x16x32_bf16(__builtin_bit_cast(bf16x8, aw), __builtin_bit_cast(bf16x8, bw), acc, 0, 0, 0); }
                u32x2 w; w.x = pk2(acc[0], acc[1]); w.y = pk2(acc[2], acc[3]);
                *(u32x2*)(stb + (et * 16 + (lane & 15)) * 64 + dt4 * 16 + (lane >> 4) * 4) = w; }
        }
    }
    lds_barrier();
}

template <int DV, bool GATED>
__device__ __forceinline__ void bla_stage2(LAS unsigned char* lds, const Bla<DV, GATED>& P, int unit, const BlaRegs<DV, GATED, true>& R, int tid) {
    const int b = unit >> 8, n = (unit >> 2) & 63, h = unit & 3;
    const int lane = tid & 63, wave = tid >> 6, j = tid >> 3, sg = tid & 7; const int tok0 = b * SEQ + n * 64;
    LAS float* bf = (LAS float*)(lds + L_BF); LAS float* bb = (LAS float*)(lds + L_BB); LAS bf16_t* vT = (LAS bf16_t*)(lds + L_VT);
    LAS bf16_t* qin = (LAS bf16_t*)(lds + L_QIN); LAS bf16_t* kin = (LAS bf16_t*)(lds + L_KIN); LAS bf16_t* Pm = (LAS bf16_t*)(lds + L_P); LAS bf16_t* ST = (LAS bf16_t*)(lds + L_ST);
    float klo[4], khi[4], qlo[4], qhi[4];
    bla_front<DV, GATED, true>(lds, R, n, h, tid, klo, khi, qlo, qhi);
    const float lgam = __logf(1.0f - __builtin_amdgcn_exp2f(-5.0f - (float)h));
    constexpr int NT = DV / 32;
    f32x4 oacc[NT];
#pragma unroll
    for (int k = 0; k < NT; ++k) oacc[k] = (f32x4){0.f, 0.f, 0.f, 0.f};
#pragma unroll
    for (int dir = 0; dir < 2; ++dir) {
        LAS const float* bx = dir ? bb : bf;
        const float bret = (float)(dir ? 64 - j : j + 1) * lgam, eq = __expf(bret), ek = __expf(-bret);
#pragma unroll
        for (int half = 0; half < 2; ++half) { float qv[4], kv4[4];
#pragma unroll
            for (int e = 0; e < 4; ++e) { const int d = half * 32 + sg * 4 + e;
                if (GATED) { const float bv = bx[j * 65 + d]; qv[e] = (half ? qhi[e] : qlo[e]) * __expf(bv); kv4[e] = (half ? khi[e] : klo[e]) * __expf(-bv); }
                else { qv[e] = (half ? qhi[e] : qlo[e]) * eq; kv4[e] = (half ? khi[e] : klo[e]) * ek; } }
            u32x2 wq, wk; wq.x = pk2(qv[0], qv[1]); wq.y = pk2(qv[2], qv[3]); wk.x = pk2(kv4[0], kv4[1]); wk.y = pk2(kv4[2], kv4[3]);
            *(LAS u32x2*)(qin + j * RS + half * 32 + sg * 4) = wq; *(LAS u32x2*)(kin + j * RS + half * 32 + sg * 4) = wk; }
#pragma unroll
        for (int q = 0; q < DV / 64; ++q) { const int sgi = tid + 512 * q, e = sgi >> 3, d8 = (sgi & 7) * 8; *(LAS u32x4*)(ST + e * RS + d8) = R.st[dir][q]; }
        lds_barrier();
#pragma unroll
        for (int k = 0; k < 2; ++k) { const int t = wave + 8 * k, it = t & 3, jt = t >> 2; f32x4 acc = {0.f, 0.f, 0.f, 0.f};
#pragma unroll
            for (int kb = 0; kb < 2; ++kb) acc = __builtin_amdgcn_mfma_f32_16x16x32_bf16(frag(qin, it * 16, kb, lane), frag(kin, jt * 16, kb, lane), acc, 0, 0, 0);
            const int jj = jt * 16 + (lane & 15);
#pragma unroll
            for (int r = 0; r < 4; ++r) { const int ii = it * 16 + (lane >> 4) * 4 + r; const bool keep = dir ? (jj > ii) : (jj <= ii); Pm[ii * RS + jj] = (bf16_t)f2bf(keep ? acc[r] : 0.f); } }
        lds_barrier();
#pragma unroll
        for (int k = 0; k < NT; ++k) { const int t = wave + 8 * k, it = t & 3, et = t >> 2;
#pragma unroll
            for (int kb = 0; kb < 2; ++kb) oacc[k] = __builtin_amdgcn_mfma_f32_16x16x32_bf16(frag(Pm, it * 16, kb, lane), frag(vT, et * 16, kb, lane), oacc[k], 0, 0, 0);
#pragma unroll
            for (int kb = 0; kb < 2; ++kb) oacc[k] = __builtin_amdgcn_mfma_f32_16x16x32_bf16(frag(qin, it * 16, kb, lane), frag(ST, et * 16, kb, lane), oacc[k], 0, 0, 0); }
        lds_barrier();
    }
    constexpr int OS = DV + 4; LAS float* ob = (LAS float*)lds; LAS const float* ngs = (LAS const float*)(lds + L_NG);
#pragma unroll
    for (int k = 0; k < NT; ++k) { const int t = wave + 8 * k, it = t & 3, et = t >> 2;
#pragma unroll
        for (int r = 0; r < 4; ++r) ob[(it * 16 + (lane >> 4) * 4 + r) * OS + et * 16 + (lane & 15)] = oacc[k][r]; }
    lds_barrier();
    {
        constexpr int NV = DV / 8; float v[NV]; float s = 0.f;
#pragma unroll
        for (int e = 0; e < NV; ++e) { v[e] = ob[j * OS + sg * NV + e]; s += v[e]; }
        if (!GATED) { s += shx(s, 1, lane); s += shx(s, 2, lane); s += shx(s, 4, lane); const float mean = s * (1.0f / DV);
#pragma unroll
            for (int e = 0; e < NV; ++e) v[e] -= mean; }
        float q = 0.f;
#pragma unroll
        for (int e = 0; e < NV; ++e) q += v[e] * v[e];
        q += shx(q, 1, lane); q += shx(q, 2, lane); q += shx(q, 4, lane);
        const float rs = __builtin_amdgcn_rsqf(q * (1.0f / DV) + EPS);
        bf16_t* op = P.out + (size_t)(tok0 + j) * P.ldo + h * DV + sg * NV;
#pragma unroll
        for (int q8 = 0; q8 < NV / 8; ++q8) { const u32x4 gw = R.og[q8]; float gt[8];
            gt[0] = bf2f(gw.x & 0xffffu); gt[1] = bf2f(gw.x >> 16); gt[2] = bf2f(gw.y & 0xffffu); gt[3] = bf2f(gw.y >> 16); gt[4] = bf2f(gw.z & 0xffffu); gt[5] = bf2f(gw.z >> 16); gt[6] = bf2f(gw.w & 0xffffu); gt[7] = bf2f(gw.w >> 16);
            float r[8];
#pragma unroll
            for (int e = 0; e < 8; ++e) { const float y = v[q8 * 8 + e] * rs * ngs[sg * NV + q8 * 8 + e]; r[e] = y * gt[e] * sigmoidf_(gt[e]); }
            u32x4 w; w.x = pk2(r[0], r[1]); w.y = pk2(r[2], r[3]); w.z = pk2(r[4], r[5]); w.w = pk2(r[6], r[7]);
            *(u32x4*)(op + q8 * 8) = w; }
    }
    lds_barrier();
}
template <int DV, bool GATED>
__device__ __forceinline__ void bla_phase1(LAS unsigned char* lds, const Bla<DV, GATED>& P, const int wv) {
    const int tid = ltid(wv), G = lgdim(); int u = lbid(), hl = -1;
    BlaRegs<DV, GATED, false> cur, nx1, nx2;
    if (u < 4096) bla_issue<DV, GATED, false>(P, u, tid, cur);
    if (u + G < 4096) bla_issue<DV, GATED, false>(P, u + G, tid, nx1);
    for (; u < 4096; u += G) {
        if (u + 2 * G < 4096) bla_issue<DV, GATED, false>(P, u + 2 * G, tid, nx2);
        if ((u & 3) != hl) { hl = u & 3; bla_head_consts<DV, GATED>(lds, P, hl, tid); }
        bla_stage1<DV, GATED>(lds, P, u, cur, tid);
        cur = nx1; nx1 = nx2;
    }
}
template <int DV, bool GATED>
__device__ __forceinline__ void bla_phase2(LAS unsigned char* lds, const Bla<DV, GATED>& P, const int wv) {
    const int tid = ltid(wv), G = lgdim(); int u = lbid(), hl = -1;
    BlaRegs<DV, GATED, true> cur, nx1, nx2;
    if (u < 4096) bla_issue<DV, GATED, true>(P, u, tid, cur);
    if (u + G < 4096) bla_issue<DV, GATED, true>(P, u + G, tid, nx1);
    for (; u < 4096; u += G) {
        if (u + 2 * G < 4096) bla_issue<DV, GATED, true>(P, u + 2 * G, tid, nx2);
        if ((u & 3) != hl) { hl = u & 3; bla_head_consts<DV, GATED>(lds, P, hl, tid); }
        bla_stage2<DV, GATED>(lds, P, u, cur, tid);
        cur = nx1; nx1 = nx2;
    }
}

__device__ __forceinline__ void bla_scan_pair(int gi, int ri, int si, bf16_t* gst, const float* gdec, bf16_t* rst, const S5In p, int l, const float* Xl, bf16_t* Uc) {
    const int gd8 = gi & 7, ge = (gi >> 3) & 127, gbhd = gi >> 10, gdir = gbhd & 1;
    bf16_t* gbase = gst + (size_t)gbhd * 64 * 128 * 64 + ge * 64 + gd8 * 8; const float* dbase = gdec + (size_t)gbhd * 64 * 64 + gd8 * 8;
    const bool hasr = ri >= 0; const int rr = hasr ? ri : 0;
    const int rd8 = rr & 7, re = (rr >> 3) & 63, rbhd = rr >> 9, rdir = rbhd & 1, rh = (rbhd >> 1) & 3;
    bf16_t* rbase = rst + (size_t)rbhd * 64 * 64 * 64 + re * 64 + rd8 * 8;
    const float cdec = __expf(64.0f * __logf(1.0f - __builtin_amdgcn_exp2f(-5.0f - (float)rh)));
    float S[8], T[8];
#pragma unroll
    for (int k = 0; k < 8; ++k) { S[k] = 0.f; T[k] = 0.f; }
    const bool hass = si >= 0; const int sx = hass ? si : 0;
    const int spp = sx & 63, sdir = (sx >> 6) & 1, sg5 = (sx >> 7) & 15, sb = sx >> 11;
    float Lr = 0.f, Li = 0.f, xr = 0.f, xi = 0.f;
    if (hass) { const float lr = p.lam_re[(size_t)l * 2048 + (sdir * 16 + sg5) * 64 + spp], li = p.lam_im[(size_t)l * 2048 + (sdir * 16 + sg5) * 64 + spp], dt = __expf(p.log_dt[l * 32 + sdir * 16 + sg5]);
        const float mag = __expf(lr * dt * 64.f); float sn, cs; sincos_turns((double)li * (double)dt * 64.0 * INV2PI, sn, cs); Lr = mag * cs; Li = mag * sn; }
    const size_t srow0 = (size_t)sg5 * 1024 + sb * 64;
#pragma unroll 1
    for (int bt = 0; bt < 8; ++bt) {
        u32x4 kw[8], rw[8]; f32x4 d0[8], d1[8];
#pragma unroll
        for (int s = 0; s < 8; ++s) { const int stp = bt * 8 + s, n = gdir ? 63 - stp : stp, nr = rdir ? 63 - stp : stp;
            kw[s] = __builtin_nontemporal_load((const u32x4*)(gbase + (size_t)n * 8192)); d0[s] = *(const f32x4*)(dbase + n * 64); d1[s] = *(const f32x4*)(dbase + n * 64 + 4);
            rw[s] = hasr ? __builtin_nontemporal_load((const u32x4*)(rbase + (size_t)nr * 4096)) : (u32x4){0u, 0u, 0u, 0u}; }
        float ar[8], ai[8];
#pragma unroll
        for (int s = 0; s < 8; ++s) { const int stp = bt * 8 + s, n5 = sdir ? 63 - stp : stp; ar[s] = hass ? Xl[(srow0 + n5) * 256 + sdir * 128 + spp] : 0.f; ai[s] = hass ? Xl[(srow0 + n5) * 256 + sdir * 128 + 64 + spp] : 0.f; }
#pragma unroll
        for (int s = 0; s < 8; ++s) { const int stp = bt * 8 + s, n = gdir ? 63 - stp : stp, nr = rdir ? 63 - stp : stp;
            { u32x4 w; w.x = pk2(S[0], S[1]); w.y = pk2(S[2], S[3]); w.z = pk2(S[4], S[5]); w.w = pk2(S[6], S[7]); *(u32x4*)(gbase + (size_t)n * 8192) = w; }
            const u32x4 k4 = kw[s];
            S[0] = d0[s][0] * S[0] + bf2f(k4.x & 0xffffu); S[1] = d0[s][1] * S[1] + bf2f(k4.x >> 16); S[2] = d0[s][2] * S[2] + bf2f(k4.y & 0xffffu); S[3] = d0[s][3] * S[3] + bf2f(k4.y >> 16);
            S[4] = d1[s][0] * S[4] + bf2f(k4.z & 0xffffu); S[5] = d1[s][1] * S[5] + bf2f(k4.z >> 16); S[6] = d1[s][2] * S[6] + bf2f(k4.w & 0xffffu); S[7] = d1[s][3] * S[7] + bf2f(k4.w >> 16);
            if (hasr) { u32x4 w; w.x = pk2(T[0], T[1]); w.y = pk2(T[2], T[3]); w.z = pk2(T[4], T[5]); w.w = pk2(T[6], T[7]); *(u32x4*)(rbase + (size_t)nr * 4096) = w;
                const u32x4 r4 = rw[s];
                T[0] = cdec * T[0] + bf2f(r4.x & 0xffffu); T[1] = cdec * T[1] + bf2f(r4.x >> 16); T[2] = cdec * T[2] + bf2f(r4.y & 0xffffu); T[3] = cdec * T[3] + bf2f(r4.y >> 16);
                T[4] = cdec * T[4] + bf2f(r4.z & 0xffffu); T[5] = cdec * T[5] + bf2f(r4.z >> 16); T[6] = cdec * T[6] + bf2f(r4.w & 0xffffu); T[7] = cdec * T[7] + bf2f(r4.w >> 16); }
            if (hass) { const int n5 = sdir ? 63 - stp : stp;
                Uc[(srow0 + n5) * 1280 + 1024 + sdir * 128 + spp] = (bf16_t)f2bf(xr); Uc[(srow0 + n5) * 1280 + 1024 + sdir * 128 + 64 + spp] = (bf16_t)f2bf(xi);
                const float nr2 = Lr * xr - Li * xi + ar[s], ni2 = Lr * xi + Li * xr + ai[s]; xr = nr2; xi = ni2; } }
    }
}
__device__ __forceinline__ void s5_scan_item(const S5In p, int l, int idx, const float* Xl, bf16_t* Uc) {
    const int pp = idx & 63, dir = (idx >> 6) & 1, g = (idx >> 7) & 15, b = idx >> 11;
    const float lr = p.lam_re[(size_t)l * 2048 + (dir * 16 + g) * 64 + pp], li = p.lam_im[(size_t)l * 2048 + (dir * 16 + g) * 64 + pp], dt = __expf(p.log_dt[l * 32 + dir * 16 + g]);
    const float mag = __expf(lr * dt * 64.f); float s, cs; sincos_turns((double)li * (double)dt * 64.0 * INV2PI, s, cs);
    const float Lr = mag * cs, Li = mag * s; float xr = 0.f, xi = 0.f;
    const size_t row0 = (size_t)g * 1024 + b * 64;
#pragma unroll 1
    for (int bt = 0; bt < 4; ++bt) { float ar[16], ai[16];
#pragma unroll
        for (int q = 0; q < 16; ++q) { const int st = bt * 16 + q, n = dir ? 63 - st : st; ar[q] = Xl[(row0 + n) * 256 + dir * 128 + pp]; ai[q] = Xl[(row0 + n) * 256 + dir * 128 + 64 + pp]; }
#pragma unroll
        for (int q = 0; q < 16; ++q) { const int st = bt * 16 + q, n = dir ? 63 - st : st;
            Uc[(row0 + n) * 1280 + 1024 + dir * 128 + pp] = (bf16_t)f2bf(xr); Uc[(row0 + n) * 1280 + 1024 + dir * 128 + 64 + pp] = (bf16_t)f2bf(xi);
            const float nr = Lr * xr - Li * xi + ar[q], ni = Lr * xi + Li * xr + ai[q]; xr = nr; xi = ni; } }
}
__device__ __forceinline__ void scan_phase(const S5In p, int l, const float* Xl, bf16_t* Uc, bf16_t* gst, const float* gdec, bf16_t* rst, const int wv) {
    const int tid = ltid(wv), G = lgdim(), blk = lbid();
    for (int base = blk; base < 256; base += G) {
        const int gi = base * 512 + tid, ri = tid < 256 ? base * 256 + tid : -1;
        bla_scan_pair(gi, ri, tid >= 384 ? base * 128 + (tid - 384) : -1, gst, gdec, rst, p, l, Xl, Uc);
    }
}

typedef const Params __attribute__((address_space(4)))* PP;
__device__ __forceinline__ PP fresh_params() {
    unsigned long long ka = (unsigned long long)__builtin_amdgcn_kernarg_segment_ptr();
    asm volatile("" : "+s"(ka));
    return (PP)ka;
}
#define WSP(T, off) ((T*)(pp->ws + (off)))
#define XB_TMO      128
#define XB_XCNT(j)  (256  + 64 * (j))
#define XB_XSUB(j)  (1280 + 64 * (j))
#define XB_XGEN(j)  (2304 + 64 * (j))
#define XB_TOP      3328
#define XB_TOPGEN   3392
#define XCD_BAR_WORDS 3456
#define XB_SPIN_CAP (1u << 18)
__device__ __forceinline__ unsigned xb_ld(unsigned* p)              { return __hip_atomic_load(p, __ATOMIC_RELAXED, __HIP_MEMORY_SCOPE_AGENT); }
__device__ __forceinline__ unsigned xb_add(unsigned* p, unsigned v) { return __hip_atomic_fetch_add(p, v, __ATOMIC_RELAXED, __HIP_MEMORY_SCOPE_AGENT); }
__device__ __forceinline__ unsigned xb_xcc_id() { return (unsigned)__builtin_amdgcn_s_getreg((3 << 11) | 20) & 0xFu; }
#define XB_SPIN(cond, bar) do { unsigned _sp = 0; while (cond) { __builtin_amdgcn_s_sleep(1); \
    if ((++_sp & 255u) == 0u) { if (xb_ld(&(bar)[XB_TMO])) break; if (_sp > XB_SPIN_CAP) { atomicAdd(&(bar)[XB_TMO], 1u); break; } } } } while (0)
__device__ __forceinline__ void xcd_barrier_complete(unsigned* bar, unsigned x, unsigned G, unsigned& nloc, unsigned& nx) {
    unsigned sum, cnt, mine, sp = 0u;
    for (;;) {
        sum = 0u; cnt = 0u; mine = 0u;
#pragma unroll
        for (unsigned j = 0; j < 16; ++j) { const unsigned c = xb_ld(&bar[XB_XCNT(j)]); sum += c; cnt += (c > 0u) ? 1u : 0u; mine = (j == x) ? c : mine; }
        if (sum == G) break;
        __builtin_amdgcn_s_sleep(1);
        if ((++sp & 255u) == 0u) { if (xb_ld(&bar[XB_TMO])) break; if (sp > XB_SPIN_CAP) { atomicAdd(&bar[XB_TMO], 1u); break; } }
    }
    nloc = mine > 0u ? mine : 1u; nx = cnt > 0u ? cnt : 1u;
}
__device__ __forceinline__ void grid_barrier(unsigned* bar, volatile LAS unsigned* st, const int wv) {
    asm volatile("s_waitcnt vmcnt(0) lgkmcnt(0)" ::: "memory");
    __syncthreads();
    if (ltid(wv) == 0) {
        const unsigned x = xb_xcc_id();
        __builtin_amdgcn_s_waitcnt(0);
        unsigned nloc = st[0], nx = st[1];
        if (nloc == 0u) { xcd_barrier_complete(bar, x, (unsigned)lgdim(), nloc, nx); st[0] = nloc; st[1] = nx; }
        const unsigned old = xb_add(&bar[XB_XSUB(x)], 1u);
        const unsigned gen = old / nloc;
        if (old + 1u == (gen + 1u) * nloc) {
            __builtin_amdgcn_fence(__ATOMIC_RELEASE, "agent");
            asm volatile("s_waitcnt vmcnt(0)" ::: "memory");
            const unsigned og = xb_add(&bar[XB_TOP], 1u);
            const unsigned tg = og / nx;
            if (og + 1u == (tg + 1u) * nx) xb_add(&bar[XB_TOPGEN], 1u);
            else XB_SPIN(xb_ld(&bar[XB_TOPGEN]) == tg, bar);
            __builtin_amdgcn_fence(__ATOMIC_ACQUIRE, "agent");
            xb_add(&bar[XB_XGEN(x)], 1u);
            asm volatile("s_waitcnt vmcnt(0)" ::: "memory");
        } else {
            XB_SPIN(xb_ld(&bar[XB_XGEN(x)]) == gen, bar);
            __builtin_amdgcn_fence(__ATOMIC_ACQUIRE, "agent");
            asm volatile("s_waitcnt vmcnt(0)" ::: "memory");
        }
    }
    __syncthreads();
}
#define GSYNC(i) do { PP pq = fresh_params(); grid_barrier((unsigned*)(pq->ws + WS_CTL), (volatile LAS unsigned*)(lds + 131072), wv); } while (0)

__global__ void __launch_bounds__(512, 2) fwd_megakernel(Params p_unused) {
    extern __shared__ __attribute__((aligned(16))) unsigned char lds_raw[];
    LAS unsigned char* lds = (LAS unsigned char*)lds_raw;
    const int wv = __builtin_amdgcn_readfirstlane((int)(threadIdx.x >> 6));
    if (threadIdx.x < 4) ((volatile LAS unsigned*)(lds + 131072))[threadIdx.x] = 0u;
    if (blockIdx.x == 0) { PP pz = fresh_params(); unsigned* bz = (unsigned*)(pz->ws + WS_CTL);
        for (int i = threadIdx.x; i < XCD_BAR_WORDS; i += 512) __hip_atomic_store(bz + i, 0u, __ATOMIC_RELAXED, __HIP_MEMORY_SCOPE_AGENT); }
    cg::this_grid().sync();
    if (threadIdx.x == 0) { PP pz = fresh_params(); (void)xb_add((unsigned*)(pz->ws + WS_CTL) + XB_XCNT(xb_xcc_id()), 1u); }

#pragma unroll 1
    for (int l = 0; l < DEPTH; ++l) {
#if !defined(NO_CONV)
        { PP pp = fresh_params(); conv_T(lds, pp->in[2] + (size_t)l * DM * 2832, DM, 2832, WSP(bf16_t, WS_WZ), 3072, MapZ(), wv); }
        { PP pp = fresh_params(); conv_T(lds, pp->in[18] + (size_t)l * DM * 3072, DM, 3072, WSP(bf16_t, WS_WG), 3072, MapId(), wv); }
        { PP pp = fresh_params(); conv_T(lds, pp->in[15] + (size_t)l * 256 * DM, 256, DM, WSP(bf16_t, WS_WA), DM, MapId(), wv); }
        { PP pp = fresh_params(); conv_T(lds, pp->in[16] + (size_t)l * 256 * 2048, 256, 2048, WSP(bf16_t, WS_WB), 2048, MapGLU(), wv); }
        { PP pp = fresh_params(); conv_T(lds, pp->in[17] + (size_t)l * 512 * DM, 512, DM, WSP(bf16_t, WS_WC), DM, MapId(), wv); }
        { PP pp = fresh_params(); conv_T(lds, pp->in[20] + (size_t)l * DM * DM, DM, DM, WSP(bf16_t, WS_WO), DM, MapId(), wv); }
        { PP pp = fresh_params(); conv_T(lds, pp->in[22] + (size_t)l * DM * DFF, DM, DFF, WSP(bf16_t, WS_W1), DFF, MapId(), wv); }
        { PP pp = fresh_params(); conv_T(lds, pp->in[23] + (size_t)l * DFF * DM, DFF, DM, WSP(bf16_t, WS_W2), DM, MapId(), wv); }
#endif
#if !defined(NO_PREP)
        { PP pp = fresh_params(); const S5In si{pp->in[4], pp->in[5], pp->in[6], pp->in[7], pp->in[8], pp->in[9], pp->in[10], pp->in[11]}; for (int u = lbid(); u < 256; u += lgdim()) s5_prep(lds, si, l, u, WSP(bf16_t, WS_T1), WSP(bf16_t, WS_T2), wv); }
#endif
        { PP pp = fresh_params(); rmsnorm_phase(l == 0 ? pp->in[0] : pp->out, nullptr, pp->in[1] + l * DM, WSP(bf16_t, WS_H), wv); }
        GSYNC(0);
        { PP pp = fresh_params(); pg8::OrderStd S; S.init(WSP(bf16_t, WS_H), DM, WSP(bf16_t, WS_WZ), DM, NTOK, 3072); pg8::EpiZ E{WSP(bf16_t, WS_Z), WSP(bf16_t, WS_UC)}; pg8::gemm_phase(lds, S, E, DM, DM, DM, wv); }
        GSYNC(1);
        { PP pp = fresh_params(); pg8::OrderBatch S; S.init(WSP(bf16_t, WS_UC), 1280, (size_t)1024 * 1280 * 2, WSP(bf16_t, WS_T1), 1024, (size_t)256 * 1024 * 2, 4, 1); pg8::EpiXloc E{WSP(float, WS_XL)}; pg8::gemm_phase(lds, S, E, 1024, 1280, 1024, wv); }
#if !defined(NO_BLA1)
        { PP pp = fresh_params(); Bla<64, false> PA{WSP(bf16_t, WS_Z) + ZR_OFF, nullptr, nullptr, nullptr, WSP(bf16_t, WS_RST), nullptr, pp->in[3] + l * 256, WSP(bf16_t, WS_RO), 256};
          bla_phase1<64, false>(lds, PA, wv); }
        { PP pp = fresh_params(); Bla<128, true> PC{WSP(bf16_t, WS_Z) + ZG_OFF, WSP(bf16_t, WS_Z) + ZL_OFF, pp->in[12] + (size_t)l * 2 * 16 * 256, pp->in[13] + l * 512, WSP(bf16_t, WS_GST), WSP(float, WS_GDEC), pp->in[14] + l * 512, WSP(bf16_t, WS_GO), 512};
          bla_phase1<128, true>(lds, PC, wv); }
#endif
        GSYNC(2);
#if !defined(NO_SCAN)
        { PP pp = fresh_params(); const S5In si{pp->in[4], pp->in[5], pp->in[6], pp->in[7], pp->in[8], pp->in[9], pp->in[10], pp->in[11]}; scan_phase(si, l, WSP(float, WS_XL), WSP(bf16_t, WS_UC), WSP(bf16_t, WS_GST), WSP(float, WS_GDEC), WSP(bf16_t, WS_RST), wv); }
#endif
        GSYNC(3);
        { PP pp = fresh_params(); pg8::OrderBatch S; S.init(WSP(bf16_t, WS_UC), 1280, (size_t)1024 * 1280 * 2, WSP(bf16_t, WS_T2), 1280, (size_t)1024 * 1280 * 2, 4, 4); pg8::EpiS5Y E{WSP(bf16_t, WS_Y)}; pg8::gemm_phase(lds, S, E, 1280, 1280, 1280, wv); }
#if !defined(NO_BLA2)
        { PP pp = fresh_params(); Bla<64, false> PA{WSP(bf16_t, WS_Z) + ZR_OFF, nullptr, nullptr, nullptr, WSP(bf16_t, WS_RST), nullptr, pp->in[3] + l * 256, WSP(bf16_t, WS_RO), 256};
          bla_phase2<64, false>(lds, PA, wv); }
        { PP pp = fresh_params(); Bla<128, true> PC{WSP(bf16_t, WS_Z) + ZG_OFF, WSP(bf16_t, WS_Z) + ZL_OFF, pp->in[12] + (size_t)l * 2 * 16 * 256, pp->in[13] + l * 512, WSP(bf16_t, WS_GST), WSP(float, WS_GDEC), pp->in[14] + l * 512, WSP(bf16_t, WS_GO), 512};
          bla_phase2<128, true>(lds, PC, wv); }
#endif
        GSYNC(4);
        { PP pp = fresh_params(); pg8::OrderStd S; S.init(WSP(bf16_t, WS_RO), 256, WSP(bf16_t, WS_WA), 256, NTOK, DM); pg8::EpiBf16<0> E{WSP(bf16_t, WS_Z), DM}; pg8::gemm_phase(lds, S, E, 256, 256, 256, wv); }
        { PP pp = fresh_params(); pg8::OrderStd S; S.init(WSP(bf16_t, WS_Y), 256, WSP(bf16_t, WS_WB), 256, NTOK, 2048); pg8::EpiGLU E{WSP(bf16_t, WS_Z) + (size_t)NTOK * DM}; pg8::gemm_phase(lds, S, E, 256, 256, 256, wv); }
        { PP pp = fresh_params(); pg8::OrderStd S; S.init(WSP(bf16_t, WS_GO), 512, WSP(bf16_t, WS_WC), 512, NTOK, DM); pg8::EpiBf16<0> E{WSP(bf16_t, WS_Z) + (size_t)2 * NTOK * DM, DM}; pg8::gemm_phase(lds, S, E, 512, 512, 512, wv); }
        GSYNC(5);
        { PP pp = fresh_params(); pg8::OrderMerge S; S.init(WSP(bf16_t, WS_H), DM, WSP(bf16_t, WS_WG), DM, NTOK); pg8::EpiMerge E{WSP(bf16_t, WS_Z), WSP(bf16_t, WS_GST), pp->in[19] + (size_t)l * 3072}; pg8::gemm_phase(lds, S, E, DM, DM, DM, wv); }
        GSYNC(6);
        { PP pp = fresh_params(); pg8::OrderStd S; S.init(WSP(bf16_t, WS_GST), DM, WSP(bf16_t, WS_WO), DM, NTOK, DM); pg8::EpiRes E{l == 0 ? pp->in[0] : pp->out, pp->out}; pg8::gemm_phase(lds, S, E, DM, DM, DM, wv); }
        GSYNC(7);
        { PP pp = fresh_params(); rmsnorm_phase(pp->out, nullptr, pp->in[21] + l * DM, WSP(bf16_t, WS_H), wv); }
        GSYNC(8);
        { PP pp = fresh_params(); pg8::OrderStd S; S.init(WSP(bf16_t, WS_H), DM, WSP(bf16_t, WS_W1), DM, NTOK, DFF); pg8::EpiBf16<1> E{WSP(bf16_t, WS_Z), DFF}; pg8::gemm_phase(lds, S, E, DM, DM, DM, wv); }
        GSYNC(9);
        { PP pp = fresh_params(); pg8::OrderStd S; S.init(WSP(bf16_t, WS_Z), DFF, WSP(bf16_t, WS_W2), DFF, NTOK, DM); pg8::EpiRes E{pp->out, pp->out}; pg8::gemm_phase(lds, S, E, DFF, DFF, DFF, wv); }
        GSYNC(10);
    }
    { PP pp = fresh_params(); final_norm_phase(pp->out, pp->in[24], wv); }
}

extern "C" void kernel_launch(void* const* d_in, const int* in_sizes, int n_in, void* d_out, int out_size, void* d_ws, size_t ws_size, hipStream_t stream) {
    static int grid_blocks = 0;
    if (grid_blocks == 0) {
        if (n_in != 25 || out_size != NTOK * DM || ws_size < WS_END) { fprintf(stderr, "kernel_launch: unexpected shapes (n_in %d out %d ws %zu need %zu)\n", n_in, out_size, ws_size, (size_t)WS_END); grid_blocks = -1; return; }
        int dev = 0, cus = 0, per_cu = 0;
        (void)hipGetDevice(&dev);
        (void)hipDeviceGetAttribute(&cus, hipDeviceAttributeMultiprocessorCount, dev);
        (void)hipFuncSetAttribute((const void*)fwd_megakernel, hipFuncAttributeMaxDynamicSharedMemorySize, LDS_BYTES);
        (void)hipOccupancyMaxActiveBlocksPerMultiprocessor(&per_cu, (const void*)fwd_megakernel, 512, LDS_BYTES);
        if (per_cu < 1) { fprintf(stderr, "kernel_launch: occupancy query says %d blocks per CU\n", per_cu); per_cu = 1; }
        (void)hipGetLastError();
        grid_blocks = cus * per_cu;
        if (grid_blocks > 256) grid_blocks = 256;
    }
    if (grid_blocks < 0) return;
    Params p{};
    for (int i = 0; i < 25; ++i) p.in[i] = (const float*)d_in[i];
    p.out = (float*)d_out; p.ws = (unsigned char*)d_ws;
    void* args[] = {&p};
    hipError_t e = hipLaunchCooperativeKernel((const void*)fwd_megakernel, dim3(grid_blocks), dim3(512), args, LDS_BYTES, stream);
    if (e != hipSuccess) fprintf(stderr, "cooperative launch failed: %s (grid %d)\n", hipGetErrorString(e), grid_blocks);
}
```

```cpp
#include <hip/hip_runtime.h>
#include <hip/hip_cooperative_groups.h>
#include <cstdio>
#include <cstdint>
namespace cg = cooperative_groups;

#define LAS __attribute__((address_space(3)))
typedef unsigned short bf16_t;
typedef short bf16x8 __attribute__((ext_vector_type(8)));
typedef float f32x4 __attribute__((ext_vector_type(4)));
typedef float f32x2 __attribute__((ext_vector_type(2)));
typedef unsigned u32x4 __attribute__((ext_vector_type(4)));
typedef unsigned u32x2 __attribute__((ext_vector_type(2)));

#ifndef EN_A
#define EN_A 1
#endif
#ifndef EN_B
#define EN_B 1
#endif
#ifndef EN_C
#define EN_C 1
#endif

constexpr int NTOK = 65536, DM = 1024, SEQ = 4096, DEPTH = 4, DFF = 4096;
constexpr int ZS = 3072;
constexpr int C_RQ = 0, C_RK = 256, C_RV = 512, C_RG = 768, C_SU = 1024, C_GQ = 1280, C_GK = 1536, C_GV = 1792, C_GR = 2304, C_LR = 2816;
constexpr int LDS_BYTES = 131072 + 16;
constexpr size_t ZR_OFF = 0, ZG_OFF = (size_t)65536 * 1024, ZL_OFF = ZG_OFF + (size_t)65536 * 1536;
constexpr float EPS = 1e-6f;

constexpr size_t WS_WZ = 0;
constexpr size_t WS_WG = WS_WZ + 6291456;
constexpr size_t WS_WA = WS_WG + 6291456;
constexpr size_t WS_WB = WS_WA + 524288;
constexpr size_t WS_WC = WS_WB + 1048576;
constexpr size_t WS_WO = WS_WC + 1048576;
constexpr size_t WS_W1 = WS_WO + 2097152;
constexpr size_t WS_W2 = WS_W1 + 8388608;
constexpr size_t WS_T1 = WS_W2 + 8388608;
constexpr size_t WS_T2 = WS_T1 + 8388608;
constexpr size_t WS_UC = WS_T2 + 41943040;
constexpr size_t WS_XL = WS_UC + 41943040;
constexpr size_t WS_H  = WS_XL + 16777216;
constexpr size_t WS_Z  = WS_H + 134217728;
constexpr size_t WS_RO = WS_Z + 402653184;
constexpr size_t WS_Y  = WS_RO + 33554432;
constexpr size_t WS_GO = WS_Y + 33554432;
constexpr size_t WS_GST = WS_GO + 67108864;
constexpr size_t WS_RST = WS_GST + 134217728;
constexpr size_t WS_GDEC = WS_RST + 67108864;
constexpr size_t WS_CTL = WS_GDEC + 2097152;
constexpr size_t WS_SL1 = WS_CTL + 16384;
constexpr size_t WS_SL2 = WS_SL1 + 4194304;
constexpr size_t WS_RS1 = WS_SL2 + 4194304;
constexpr size_t WS_RS2 = WS_RS1 + 262144;
constexpr size_t WS_END = WS_RS2 + 262144;

struct Params { const float* in[25]; float* out; unsigned char* ws; };
struct S5In { const float *lam_re, *lam_im, *log_dt, *b_re, *b_im, *c_re, *c_im, *d; };

__device__ __forceinline__ float bf2f(unsigned b) { return __uint_as_float(b << 16); }
typedef __bf16 bf16v2_t __attribute__((ext_vector_type(2)));
__device__ __forceinline__ unsigned pk2(float lo, float hi) { const f32x2 v = {lo, hi}; const bf16v2_t b = __builtin_convertvector(v, bf16v2_t); return __builtin_bit_cast(unsigned, b); }
__device__ __forceinline__ unsigned f2bf(float f) { return pk2(f, f) & 0xffffu; }

__device__ __forceinline__ float sigmoidf_(float x) { return __builtin_amdgcn_rcpf(1.0f + __expf(-x)); }
__device__ __forceinline__ void sincos_turns(double turns, float& s, float& c) { turns -= rint(turns); const float t = (float)turns; s = __builtin_amdgcn_sinf(t); c = __builtin_amdgcn_cosf(t); }
__device__ __forceinline__ int ltid(int wv) { int lane; asm volatile("v_mbcnt_lo_u32_b32 %0, -1, 0\n\tv_mbcnt_hi_u32_b32 %0, -1, %0" : "=v"(lane)); return wv * 64 + lane; }
__device__ __forceinline__ int lbid() { int t = blockIdx.x; asm volatile("" : "+s"(t)); return t; }
__device__ __forceinline__ int lgdim() { int t = gridDim.x; asm volatile("" : "+s"(t)); return t; }
__device__ __forceinline__ float shx(float v, int mask, int lane) { return __int_as_float(__builtin_amdgcn_ds_bpermute((lane ^ mask) << 2, __float_as_int(v))); }
constexpr double INV2PI = 0.15915494309189533577;
__device__ __forceinline__ f32x2 gelu_pk(f32x2 v) {
    const f32x2 av = __builtin_elementwise_abs(v), d = av * 0.2316418882f + 1.0f;
    f32x2 t; t.x = __builtin_amdgcn_rcpf(d.x); t.y = __builtin_amdgcn_rcpf(d.y);
    f32x2 q = t * 0.5307027145f + (-0.7265760135f); q = q * t + 0.7107068705f; q = q * t + (-0.142248368f); q = q * t + 0.127414796f; q = q * t;
    const f32x2 s = (v * v) * (-0.72134752044f);
    f32x2 e; e.x = __builtin_amdgcn_exp2f(s.x); e.y = __builtin_amdgcn_exp2f(s.y);
    const f32x2 m = v * (q * e), r = v - m;
    f32x2 o; o.x = v.x < 0.f ? m.x : r.x; o.y = v.y < 0.f ? m.y : r.y; return o;
}

namespace pg8 {
constexpr int BM = 256, BK = 64, HALF = 128, HTB = HALF * BK * 2, STAGE_BYTES = 8 * HTB, NXCD = 8, WGM = 8;
__device__ __forceinline__ int lds_byte(int r, int c) { const int st = (r >> 4) * 2 + (c >> 5), rr = r & 15, cc = c & 31, ob = rr * 64 + cc * 2; return st * 1024 + (ob ^ (((ob >> 9) & 1) << 5)); }
__device__ __forceinline__ void stage_rc(int b, int& R, int& C) { const int st = b / 1024, sb = b % 1024, swz = sb ^ (((sb >> 9) & 1) << 5); R = (st >> 1) * 16 + swz / 64; C = (st & 1) * 32 + (swz % 64) / 2; }
__device__ __forceinline__ int perm32(int rho) { const int n = rho >> 4, i = rho & 15; return 8 * (i >> 2) + 4 * n + (i & 3); }

struct Unit { int pm, pn, bt; };

__device__ __forceinline__ void remap(int L, int nM, int nN, int& pm, int& pn) {
    const int nwg = nM * nN; int wgid = L;
    { const int q = nwg / NXCD, r = nwg % NXCD, xcd = wgid % NXCD, off = wgid / NXCD; wgid = (xcd < r ? xcd * (q + 1) : r * (q + 1) + (xcd - r) * q) + off; }
    const int nig = WGM * nN, gid = wgid / nig, fm = gid * WGM, gsz = (nM - fm) < WGM ? (nM - fm) : WGM;
    pm = fm + ((wgid % nig) % gsz); pn = (wgid % nig) / gsz;
}
struct OrderStd {
    const char* A; const char* Bt; int nM, nN, G, c; size_t tA, tB;
    __device__ __forceinline__ void init(const void* A_, int lda, const void* Bt_, int ldb, int M, int N) { A = (const char*)A_; Bt = (const char*)Bt_; nM = M / BM; nN = N / BM; G = lgdim(); c = lbid(); tA = (size_t)BM * lda * 2; tB = (size_t)BM * ldb * 2; }
    __device__ __forceinline__ bool next(int i, Unit& u) const { const long L = (long)i * G + c; if (L >= (long)nM * nN) return false; remap((int)L, nM, nN, u.pm, u.pn); u.bt = 0; return true; }
    __device__ __forceinline__ const char* a_ptr(const Unit& u) const { return A + (size_t)u.pm * tA; }
    __device__ __forceinline__ const char* b_ptr(const Unit& u) const { return Bt + (size_t)u.pn * tB; }
};
struct OrderMerge {
    const char* A; const char* Bt; int nM, G, c; size_t tA, tB;
    __device__ __forceinline__ void init(const void* A_, int lda, const void* Bt_, int ldb, int M) { A = (const char*)A_; Bt = (const char*)Bt_; nM = M / BM; G = lgdim(); c = lbid(); tA = (size_t)BM * lda * 2; tB = (size_t)BM * ldb * 2; }
    __device__ __forceinline__ bool next(int i, Unit& u) const { const int sup = i / 3, seg = i - sup * 3; const long L = (long)sup * G + c; if (L >= (long)nM * 4) return false; int j; remap((int)L, nM, 4, u.pm, j); u.pn = seg * 4 + j; u.bt = 0; return true; }
    __device__ __forceinline__ const char* a_ptr(const Unit& u) const { return A + (size_t)u.pm * tA; }
    __device__ __forceinline__ const char* b_ptr(const Unit& u) const { return Bt + (size_t)u.pn * tB; }
};
struct OrderBatch {
    const char* A; const char* Bt; int nM, nN, G, c; size_t tA, tB, gA, gB;
    __device__ __forceinline__ void init(const void* A_, int lda, size_t gA_, const void* Bt_, int ldb, size_t gB_, int nM_, int nN_) { A = (const char*)A_; Bt = (const char*)Bt_; nM = nM_; nN = nN_; G = lgdim(); c = lbid(); tA = (size_t)BM * lda * 2; tB = (size_t)BM * ldb * 2; gA = gA_; gB = gB_; }
    __device__ __forceinline__ bool next(int i, Unit& u) const {
        const long L = (long)i * G + c; const int per = nM * nN; if (L >= 16L * per) return false;
        const int x = (int)(L & 7), r = (int)(L >> 3), npx = 2 * per;
        const int g = 2 * x + r / per, t = r % per; (void)npx;
        u.bt = g; u.pm = t / nN; u.pn = t % nN; return true; }
    __device__ __forceinline__ const char* a_ptr(const Unit& u) const { return A + (size_t)u.bt * gA + (size_t)u.pm * tA; }
    __device__ __forceinline__ const char* b_ptr(const Unit& u) const { return Bt + (size_t)u.bt * gB + (size_t)u.pn * tB; }
};

template <bool ALIGN_EPI = true, bool SP2 = true, class Epi, class Sched>
__device__ __forceinline__ void gemm_phase(LAS unsigned char* lds, const Sched& S, const Epi& E, const int K, const int lda, const int ldb, const int wv) {
    int tid_ = ltid(wv);
    const int tid = tid_, wid = __builtin_amdgcn_readfirstlane(tid >> 6), lane = tid & 63, wr = wid >> 2, wc = wid & 3, fr = lane & 15, fq = lane >> 4;
    const int nt = K / BK;
    unsigned voffA[2], voffB[2];
#pragma unroll
    for (int i = 0; i < 2; ++i) { int R, C; stage_rc(tid * 16 + i * 8192, R, C); const int Rb = Epi::PERM ? ((R & ~31) + perm32(R & 31)) : R;
        voffA[i] = (unsigned)(R * lda + C) * 2u; voffB[i] = (unsigned)(Rb * ldb + C) * 2u; }
    const size_t kstep = (size_t)(BK * 2);
    const size_t hstepA = (size_t)HALF * lda * 2, hstepB = (size_t)HALF * ldb * 2;
    const unsigned ldsw = (unsigned)wid * 1024u;
    const int aoff = lds_byte(wr * 64 + fr, fq * 8), boff = lds_byte(wc * 32 + fr, fq * 8);
#define PG8_SA(b, h) (((b) * 2 + (h)) * HTB)
#define PG8_SB(b, h) ((4 + (b) * 2 + (h)) * HTB)
#define PG8_STAGE(bufoff, gbase, voff) do { _Pragma("unroll") for (int _i = 0; _i < 2; ++_i) \
        __builtin_amdgcn_global_load_lds((const unsigned*)((const char*)(gbase) + (voff)[_i]), (LAS unsigned*)(lds + (bufoff) + ldsw + _i * 8192), 16, 0, 0); } while (0)
#define PG8_LDA(dst, b, h) do { _Pragma("unroll") for (int m = 0; m < 4; ++m) _Pragma("unroll") for (int k = 0; k < 2; ++k) dst[m][k] = *(const LAS bf16x8*)(lds + PG8_SA(b, h) + aoff + m * 2048 + k * 1024); } while (0)
#define PG8_LDB(dst, b, h) do { _Pragma("unroll") for (int n = 0; n < 2; ++n) _Pragma("unroll") for (int k = 0; k < 2; ++k) dst[n][k] = *(const LAS bf16x8*)(lds + PG8_SB(b, h) + boff + n * 2048 + k * 1024); } while (0)
#define PG8_MMA(ai, bj, At, Bt) do { __builtin_amdgcn_s_setprio(1); _Pragma("unroll") for (int m = 0; m < 4; ++m) _Pragma("unroll") for (int n = 0; n < 2; ++n) _Pragma("unroll") for (int k = 0; k < 2; ++k) \
        acc[ai][bj][m][n] = __builtin_amdgcn_mfma_f32_16x16x32_bf16(Bt[n][k], At[m][k], acc[ai][bj][m][n], 0, 0, 0); __builtin_amdgcn_s_setprio(0); } while (0)
#define PG8_WAIT_V(n) asm volatile("s_waitcnt vmcnt(" #n ")" ::: "memory")
#define PG8_WAIT_L(n) asm volatile("s_waitcnt lgkmcnt(" #n ")" ::: "memory")
#define PG8_BAR __builtin_amdgcn_s_barrier()
#define PG8_SCHED __builtin_amdgcn_sched_barrier(0)
    Unit cur, nxt; int ui = 0;
    if (!S.next(0, cur)) return;
    f32x4 acc[2][2][4][2];
#pragma unroll
    for (int a = 0; a < 2; ++a)
#pragma unroll
        for (int b = 0; b < 2; ++b)
#pragma unroll
            for (int m = 0; m < 4; ++m)
#pragma unroll
                for (int n = 0; n < 2; ++n) acc[a][b][m][n] = (f32x4){0.f, 0.f, 0.f, 0.f};
    bf16x8 At[4][2], B0[2][2], B1[2][2];
    const char* cA = S.a_ptr(cur); const char* cB = S.b_ptr(cur);
    if constexpr (SP2) {
        PG8_STAGE(PG8_SB(0, 0), cB, voffB); PG8_STAGE(PG8_SB(0, 1), cB + hstepB, voffB); PG8_STAGE(PG8_SA(0, 0), cA, voffA); PG8_STAGE(PG8_SA(0, 1), cA + hstepA, voffA);
        if (wr == 1) PG8_BAR;
        PG8_WAIT_V(2); PG8_BAR;
        PG8_STAGE(PG8_SB(1, 0), cB + kstep, voffB); PG8_STAGE(PG8_SA(1, 0), cA + kstep, voffA); PG8_STAGE(PG8_SB(1, 1), cB + hstepB + kstep, voffB);
        PG8_WAIT_V(6); PG8_BAR;
    } else {
    PG8_STAGE(PG8_SB(0, 0), cB, voffB); PG8_STAGE(PG8_SA(0, 0), cA, voffA); PG8_STAGE(PG8_SB(0, 1), cB + hstepB, voffB); PG8_STAGE(PG8_SA(0, 1), cA + hstepA, voffA);
    if (wr == 1) PG8_BAR;
    PG8_WAIT_V(4); PG8_BAR;
    PG8_STAGE(PG8_SB(1, 0), cB + kstep, voffB); PG8_STAGE(PG8_SA(1, 0), cA + kstep, voffA); PG8_STAGE(PG8_SB(1, 1), cB + hstepB + kstep, voffB);
    PG8_WAIT_V(6); PG8_BAR;
    }
    for (;;) {
        const bool has_next = S.next(ui + 1, nxt);
        float rsv[8];
        if constexpr (Epi::NEEDS_RS) { const int l3 = ltid(wv) & 15; const float* rp = E.rs + cur.pm * BM + wr * 64 + l3;
#pragma unroll
            for (int q8 = 0; q8 < 8; ++q8) rsv[q8] = rp[(q8 >> 2) * HALF + (q8 & 3) * 16]; }
        const char* nA = has_next ? S.a_ptr(nxt) : cA; const char* nB = has_next ? S.b_ptr(nxt) : cB;
        for (int t = 0; t < nt; t += 2) {
            const bool last = (t == nt - 2);
            const char* a1 = cA + (size_t)(t + 1) * kstep;
            const char* a2 = last ? nA : cA + (size_t)(t + 2) * kstep; const char* b2 = last ? nB : cB + (size_t)(t + 2) * kstep;
            const char* a3 = a2 + kstep; const char* b3 = b2 + kstep;
            if constexpr (SP2) {
            PG8_LDB(B0, 0, 0); PG8_LDB(B1, 0, 1); PG8_SCHED; PG8_LDA(At, 0, 0); PG8_STAGE(PG8_SA(1, 1), a1 + hstepA, voffA);
            PG8_WAIT_V(8); PG8_WAIT_L(0); PG8_BAR; PG8_MMA(0, 0, At, B0); PG8_MMA(0, 1, At, B1); PG8_BAR; PG8_SCHED;
            PG8_LDA(At, 0, 1); PG8_STAGE(PG8_SB(0, 0), b2, voffB); PG8_STAGE(PG8_SB(0, 1), b2 + hstepB, voffB); PG8_STAGE(PG8_SA(0, 0), a2, voffA);
            PG8_WAIT_V(8); PG8_WAIT_L(0); PG8_BAR; PG8_MMA(1, 0, At, B0); PG8_MMA(1, 1, At, B1); PG8_BAR; PG8_SCHED;
            PG8_LDB(B0, 1, 0); PG8_LDB(B1, 1, 1); PG8_SCHED; PG8_LDA(At, 1, 0); PG8_STAGE(PG8_SA(0, 1), a2 + hstepA, voffA);
            PG8_WAIT_V(8); PG8_WAIT_L(0); PG8_BAR; PG8_MMA(0, 0, At, B0); PG8_MMA(0, 1, At, B1); PG8_BAR; PG8_SCHED;
            PG8_LDA(At, 1, 1); PG8_STAGE(PG8_SB(1, 0), b3, voffB); PG8_STAGE(PG8_SB(1, 1), b3 + hstepB, voffB); PG8_STAGE(PG8_SA(1, 0), a3, voffA);
            PG8_WAIT_V(8); PG8_WAIT_L(0); PG8_BAR; PG8_MMA(1, 0, At, B0); PG8_MMA(1, 1, At, B1); PG8_BAR; PG8_SCHED;
            } else {
            PG8_LDB(B0, 0, 0); PG8_SCHED; PG8_LDA(At, 0, 0); PG8_STAGE(PG8_SA(1, 1), a1 + hstepA, voffA);
            PG8_WAIT_L(8); PG8_BAR; PG8_WAIT_L(0); PG8_MMA(0, 0, At, B0); PG8_BAR; PG8_SCHED;
            PG8_LDB(B1, 0, 1); PG8_STAGE(PG8_SB(0, 0), b2, voffB);
            PG8_BAR; PG8_WAIT_L(0); PG8_MMA(0, 1, At, B1); PG8_BAR;
            PG8_LDA(At, 0, 1); PG8_STAGE(PG8_SA(0, 0), a2, voffA);
            PG8_BAR; PG8_WAIT_L(0); PG8_MMA(1, 0, At, B0); PG8_BAR; PG8_SCHED;
            PG8_STAGE(PG8_SB(0, 1), b2 + hstepB, voffB);
            PG8_WAIT_V(6); PG8_BAR; PG8_MMA(1, 1, At, B1); PG8_BAR;
            PG8_LDB(B0, 1, 0); PG8_SCHED; PG8_LDA(At, 1, 0); PG8_STAGE(PG8_SA(0, 1), a2 + hstepA, voffA);
            PG8_WAIT_L(8); PG8_BAR; PG8_WAIT_L(0); PG8_MMA(0, 0, At, B0); PG8_BAR; PG8_SCHED;
            PG8_LDB(B1, 1, 1); PG8_STAGE(PG8_SB(1, 0), b3, voffB);
            PG8_BAR; PG8_WAIT_L(0); PG8_MMA(0, 1, At, B1); PG8_BAR;
            PG8_LDA(At, 1, 1); PG8_STAGE(PG8_SA(1, 0), a3, voffA);
            PG8_BAR; PG8_WAIT_L(0); PG8_MMA(1, 0, At, B0); PG8_BAR; PG8_SCHED;
            PG8_STAGE(PG8_SB(1, 1), b3 + hstepB, voffB);
            PG8_WAIT_V(6); PG8_BAR; PG8_MMA(1, 1, At, B1); PG8_BAR;
            }
        }
        if constexpr (ALIGN_EPI) { if (wr == 0) PG8_BAR; }
        { const int l2 = ltid(wv) & 63; E(acc, cur, wr, wc, l2 & 15, l2 >> 4, rsv); }
        if (!has_next) break;
#pragma unroll
        for (int a = 0; a < 2; ++a)
#pragma unroll
            for (int b = 0; b < 2; ++b)
#pragma unroll
                for (int m = 0; m < 4; ++m)
#pragma unroll
                    for (int n = 0; n < 2; ++n) acc[a][b][m][n] = (f32x4){0.f, 0.f, 0.f, 0.f};
        cur = nxt; cA = nA; cB = nB; ++ui;
        if constexpr (ALIGN_EPI) { if (wr == 1) PG8_BAR; }
    }
    PG8_WAIT_V(0);
    if constexpr (!ALIGN_EPI) { if (wr == 0) PG8_BAR; }
    PG8_BAR;
#undef PG8_SA
#undef PG8_SB
#undef PG8_STAGE
#undef PG8_LDA
#undef PG8_LDB
#undef PG8_MMA
#undef PG8_WAIT_V
#undef PG8_WAIT_L
#undef PG8_BAR
#undef PG8_SCHED
}

typedef const f32x4 (&AccRef)[2][2][4][2];

struct EpiZ {
    static constexpr bool PERM = true; static constexpr bool NEEDS_RS = true; bf16_t* z; bf16_t* uc; const float* rs;
    __device__ __forceinline__ void operator()(AccRef acc, const Unit& u, int wr, int wc, int fr, int fq, const float (&rsv)[8]) const {
        const int row0 = u.pm * BM + wr * 64 + fr;
#pragma unroll
        for (int ai = 0; ai < 2; ++ai)
#pragma unroll
            for (int m = 0; m < 4; ++m) { const int r = row0 + ai * HALF + m * 16;
#pragma unroll
                for (int bj = 0; bj < 2; ++bj) { const f32x4 v0 = acc[ai][bj][m][0] * rsv[ai * 4 + m], v1 = acc[ai][bj][m][1] * rsv[ai * 4 + m];
                    u32x4 w; w.x = pk2(v0[0], v0[1]); w.y = pk2(v0[2], v0[3]); w.z = pk2(v1[0], v1[1]); w.w = pk2(v1[2], v1[3]);
                    const int c0 = u.pn * BM + bj * HALF + wc * 32 + 8 * fq;
                    if (u.pn == 4) { const int cc = c0 - C_SU, g = cc >> 4, c8 = cc & 15, b = r >> 12, t = r & 4095;
                        *(u32x4*)(uc + ((size_t)(g * 1024 + b * 64 + (t >> 6)) * 1280 + (t & 63) * 16 + c8)) = w; }
                    else { const int tb = r >> 6, i = r & 63; size_t off;
                        if (c0 < 1024) off = ZR_OFF + ((size_t)(tb * 4 + ((c0 >> 6) & 3)) * 64 + i) * 256 + (c0 >> 8) * 64 + (c0 & 63);
                        else if (c0 < C_GV) off = ZG_OFF + ((size_t)(tb * 4 + (((c0 - C_GQ) >> 6) & 3)) * 64 + i) * 384 + ((c0 - C_GQ) >> 8) * 64 + (c0 & 63);
                        else if (c0 < C_LR) { const int cc = c0 - C_GV, sec = cc >> 9, hh = (cc >> 7) & 3; off = ZG_OFF + ((size_t)(tb * 4 + hh) * 64 + i) * 384 + 128 + sec * 128 + (cc & 127); }
                        else off = ZL_OFF + (size_t)r * 16 + (c0 - C_LR);
                        if (c0 < C_LR + 16) *(u32x4*)(z + off) = w; } } }
    }
};
struct EpiXloc {
    static constexpr bool PERM = false; static constexpr bool NEEDS_RS = false; float* X;
    __device__ __forceinline__ void operator()(AccRef acc, const Unit& u, int wr, int wc, int fr, int fq, const float (&rsv)[8]) const {
        float* base = X + (size_t)u.bt * 1024 * 256; const int row0 = u.pm * BM + wr * 64 + fr, col0 = wc * 32 + 4 * fq;
#pragma unroll
        for (int ai = 0; ai < 2; ++ai)
#pragma unroll
            for (int m = 0; m < 4; ++m) { float* rowp = base + (size_t)(row0 + ai * HALF + m * 16) * 256 + col0;
#pragma unroll
                for (int bj = 0; bj < 2; ++bj)
#pragma unroll
                    for (int n = 0; n < 2; ++n) *(f32x4*)(rowp + bj * HALF + n * 16) = acc[ai][bj][m][n]; }
    }
};
struct EpiS5Y {
    static constexpr bool PERM = true; static constexpr bool NEEDS_RS = false; bf16_t* Y;
    __device__ __forceinline__ void operator()(AccRef acc, const Unit& u, int wr, int wc, int fr, int fq, const float (&rsv)[8]) const {
        const int row0 = u.pm * BM + wr * 64 + fr;
#pragma unroll
        for (int ai = 0; ai < 2; ++ai)
#pragma unroll
            for (int m = 0; m < 4; ++m) { const int r = row0 + ai * HALF + m * 16;
                const int b = r >> 6, n = r & 63;
#pragma unroll
                for (int bj = 0; bj < 2; ++bj) { const f32x4 v0 = acc[ai][bj][m][0], v1 = acc[ai][bj][m][1];
                    const f32x2 a = gelu_pk((f32x2){v0[0], v0[1]}), bb = gelu_pk((f32x2){v0[2], v0[3]}), c = gelu_pk((f32x2){v1[0], v1[1]}), d = gelu_pk((f32x2){v1[2], v1[3]});
                    u32x4 w; w.x = pk2(a.x, a.y); w.y = pk2(bb.x, bb.y); w.z = pk2(c.x, c.y); w.w = pk2(d.x, d.y);
                    const int c0 = u.pn * BM + bj * HALF + wc * 32 + 8 * fq, t = c0 >> 4, c8 = c0 & 15;
                    *(u32x4*)(Y + (size_t)(b * SEQ + n * 64 + t) * 256 + u.bt * 16 + c8) = w; } }
    }
};
template <int ACT  > struct EpiBf16 {
    static constexpr bool PERM = true; static constexpr bool NEEDS_RS = (ACT == 1); bf16_t* O; int ldc; const float* rs;
    __device__ __forceinline__ void operator()(AccRef acc, const Unit& u, int wr, int wc, int fr, int fq, const float (&rsv)[8]) const {
        const int row0 = u.pm * BM + wr * 64 + fr, col0 = u.pn * BM + wc * 32 + 8 * fq;
#pragma unroll
        for (int ai = 0; ai < 2; ++ai)
#pragma unroll
            for (int m = 0; m < 4; ++m) { bf16_t* rowp = O + (size_t)(row0 + ai * HALF + m * 16) * ldc + col0;
#pragma unroll
                for (int bj = 0; bj < 2; ++bj) { f32x4 v0 = acc[ai][bj][m][0], v1 = acc[ai][bj][m][1];
                    if (ACT == 1) { v0 = v0 * rsv[ai * 4 + m]; v1 = v1 * rsv[ai * 4 + m]; }
                    if (ACT == 1) {
#pragma unroll
                        for (int j = 0; j < 4; ++j) { const float a = __builtin_amdgcn_fmed3f(v0[j], 0.f, 3.0e38f), b = __builtin_amdgcn_fmed3f(v1[j], 0.f, 3.0e38f); v0[j] = a * a; v1[j] = b * b; } }
                    u32x4 w; w.x = pk2(v0[0], v0[1]); w.y = pk2(v0[2], v0[3]); w.z = pk2(v1[0], v1[1]); w.w = pk2(v1[2], v1[3]);
                    *(u32x4*)(rowp + bj * HALF) = w; } }
    }
};
struct EpiGLU {
    static constexpr bool PERM = true; static constexpr bool NEEDS_RS = false; bf16_t* O;
    __device__ __forceinline__ void operator()(AccRef acc, const Unit& u, int wr, int wc, int fr, int fq, const float (&rsv)[8]) const {
        const int row0 = u.pm * BM + wr * 64 + fr, col0 = u.pn * HALF + wc * 32 + 8 * fq;
#pragma unroll
        for (int ai = 0; ai < 2; ++ai)
#pragma unroll
            for (int m = 0; m < 4; ++m) { bf16_t* rowp = O + (size_t)(row0 + ai * HALF + m * 16) * DM + col0;
                f32x4 v0 = acc[ai][0][m][0], v1 = acc[ai][0][m][1]; const f32x4 g0 = acc[ai][1][m][0], g1 = acc[ai][1][m][1];
#pragma unroll
                for (int j = 0; j < 4; ++j) { v0[j] *= sigmoidf_(g0[j]); v1[j] *= sigmoidf_(g1[j]); }
                u32x4 w; w.x = pk2(v0[0], v0[1]); w.y = pk2(v0[2], v0[3]); w.z = pk2(v1[0], v1[1]); w.w = pk2(v1[2], v1[3]);
                *(u32x4*)rowp = w; }
    }
};
struct EpiMerge {
    static constexpr bool PERM = true; static constexpr bool NEEDS_RS = true; const bf16_t* br; bf16_t* mg; const float* bias; const float* rs;
    __device__ __forceinline__ void operator()(AccRef acc, const Unit& u, int wr, int wc, int fr, int fq, const float (&rsv)[8]) const {
        const int seg = u.pn >> 2, j = u.pn & 3;
        const int row0 = u.pm * BM + wr * 64 + fr, ch0 = j * BM + wc * 32 + 8 * fq;
        const bf16_t* brs = br + (size_t)seg * NTOK * DM;
        f32x4 bv[2][2];
#pragma unroll
        for (int bj = 0; bj < 2; ++bj)
#pragma unroll
            for (int n = 0; n < 2; ++n) bv[bj][n] = *(const f32x4*)(bias + seg * DM + ch0 + bj * HALF + 4 * n);
#pragma unroll
        for (int ai = 0; ai < 2; ++ai)
#pragma unroll
            for (int m = 0; m < 4; ++m) { const size_t ro = (size_t)(row0 + ai * HALF + m * 16) * DM + ch0;
#pragma unroll
                for (int bj = 0; bj < 2; ++bj) { const f32x4 a0 = acc[ai][bj][m][0] * rsv[ai * 4 + m] + bv[bj][0], a1 = acc[ai][bj][m][1] * rsv[ai * 4 + m] + bv[bj][1];
                    const u32x4 bw = *(const u32x4*)(brs + ro + bj * HALF);
                    float r[8];
                    r[0] = bf2f(bw.x & 0xffffu) * sigmoidf_(a0[0]); r[1] = bf2f(bw.x >> 16) * sigmoidf_(a0[1]); r[2] = bf2f(bw.y & 0xffffu) * sigmoidf_(a0[2]); r[3] = bf2f(bw.y >> 16) * sigmoidf_(a0[3]);
                    r[4] = bf2f(bw.z & 0xffffu) * sigmoidf_(a1[0]); r[5] = bf2f(bw.z >> 16) * sigmoidf_(a1[1]); r[6] = bf2f(bw.w & 0xffffu) * sigmoidf_(a1[2]); r[7] = bf2f(bw.w >> 16) * sigmoidf_(a1[3]);
                    if (seg != 0) { const u32x4 mw = *(const u32x4*)(mg + ro + bj * HALF);
                        r[0] += bf2f(mw.x & 0xffffu); r[1] += bf2f(mw.x >> 16); r[2] += bf2f(mw.y & 0xffffu); r[3] += bf2f(mw.y >> 16);
                        r[4] += bf2f(mw.z & 0xffffu); r[5] += bf2f(mw.z >> 16); r[6] += bf2f(mw.w & 0xffffu); r[7] += bf2f(mw.w >> 16); }
                    u32x4 w; w.x = pk2(r[0], r[1]); w.y = pk2(r[2], r[3]); w.z = pk2(r[4], r[5]); w.w = pk2(r[6], r[7]);
                    *(u32x4*)(mg + ro + bj * HALF) = w; } }
    }
};
struct EpiResNorm {
    static constexpr bool PERM = true; static constexpr bool NEEDS_RS = false; static constexpr int PMODE = 1; const float* Xin; float* X; bf16_t* XG; const float* g; float* slots;
    __device__ __forceinline__ void operator()(AccRef acc, const Unit& u, int wr, int wc, int fr, int fq, const float (&rsv)[8]) const {
        const int row0 = u.pm * BM + wr * 64 + fr, col0 = u.pn * BM + wc * 32 + 8 * fq, lane = fq * 16 + fr;
        f32x4 gv[2][2];
#pragma unroll
        for (int bj = 0; bj < 2; ++bj)
#pragma unroll
            for (int n = 0; n < 2; ++n) gv[bj][n] = XG ? *(const f32x4*)(g + col0 + bj * HALF + n * 4) : (f32x4){0.f, 0.f, 0.f, 0.f};
#pragma unroll
        for (int ai = 0; ai < 2; ++ai)
#pragma unroll
            for (int m = 0; m < 4; ++m) { const int r = row0 + ai * HALF + m * 16; const size_t ro = (size_t)r * DM + col0; float ss = 0.f;
#pragma unroll
                for (int bj = 0; bj < 2; ++bj) { const f32x4* qi = (const f32x4*)(Xin + ro + bj * HALF); f32x4* qo = (f32x4*)(X + ro + bj * HALF);
                    const f32x4 v0 = qi[0] + acc[ai][bj][m][0], v1 = qi[1] + acc[ai][bj][m][1]; qo[0] = v0; qo[1] = v1;
                    ss += (v0[0] * v0[0] + v0[1] * v0[1]) + (v0[2] * v0[2] + v0[3] * v0[3]) + (v1[0] * v1[0] + v1[1] * v1[1]) + (v1[2] * v1[2] + v1[3] * v1[3]);
                    if (XG) { const f32x4 y0 = v0 * gv[bj][0], y1 = v1 * gv[bj][1]; u32x4 w; w.x = pk2(y0[0], y0[1]); w.y = pk2(y0[2], y0[3]); w.z = pk2(y1[0], y1[1]); w.w = pk2(y1[2], y1[3]);
                        *(u32x4*)(XG + ro + bj * HALF) = w; } }
                ss += shx(ss, 16, lane); ss += shx(ss, 32, lane);
                if (fq == 0) slots[(size_t)r * 16 + u.pn * 4 + wc] = ss; }
    }
};
}

__device__ __forceinline__ float wave_sum(float v, int lane) {
#pragma unroll
    for (int o = 1; o < 64; o <<= 1) v += shx(v, o, lane);
    return v;
}
__device__ __forceinline__ void rmsnorm_phase(const float* xin, float* xcopy, const float* g, bf16_t* h, const int wv) {
    const int tid = ltid(wv), lane = tid & 63, wave = tid >> 6, step = lgdim() * 8;
    f32x4 gv[4];
#pragma unroll
    for (int i = 0; i < 4; ++i) gv[i] = *(const f32x4*)(g + i * 256 + lane * 4);
    int row = lbid() * 8 + wave; f32x4 v[4], nv[4];
    if (row < NTOK) {
#pragma unroll
        for (int i = 0; i < 4; ++i) v[i] = *(const f32x4*)(xin + (size_t)row * DM + i * 256 + lane * 4); }
    for (; row < NTOK; row += step) {
        if (row + step < NTOK) {
#pragma unroll
            for (int i = 0; i < 4; ++i) nv[i] = *(const f32x4*)(xin + (size_t)(row + step) * DM + i * 256 + lane * 4); }
        float s = 0.f;
#pragma unroll
        for (int i = 0; i < 4; ++i) s += v[i][0] * v[i][0] + v[i][1] * v[i][1] + v[i][2] * v[i][2] + v[i][3] * v[i][3];
        s = wave_sum(s, lane); const float rs = __builtin_amdgcn_rsqf(s * (1.0f / DM) + EPS);
#pragma unroll
        for (int i = 0; i < 4; ++i) { u32x2 w; w.x = pk2(v[i][0] * rs * gv[i][0], v[i][1] * rs * gv[i][1]); w.y = pk2(v[i][2] * rs * gv[i][2], v[i][3] * rs * gv[i][3]);
            *(u32x2*)(h + (size_t)row * DM + i * 256 + lane * 4) = w;
            if (xcopy) *(f32x4*)(xcopy + (size_t)row * DM + i * 256 + lane * 4) = v[i]; }
#pragma unroll
        for (int i = 0; i < 4; ++i) v[i] = nv[i];
    }
}
__device__ __forceinline__ float slot_rs(const float* slots, int r) { const f32x4* p = (const f32x4*)(slots + (size_t)r * 16); const f32x4 a = p[0], b = p[1], c = p[2], d = p[3];
    const float s = ((a[0] + a[1]) + (a[2] + a[3])) + ((b[0] + b[1]) + (b[2] + b[3])) + ((c[0] + c[1]) + (c[2] + c[3])) + ((d[0] + d[1]) + (d[2] + d[3]));
    return __builtin_amdgcn_rsqf(s * (1.0f / DM) + EPS); }
__device__ __forceinline__ void rs_phase(const float* slots, float* rs, const int wv) { for (int r = lbid() * 512 + ltid(wv); r < NTOK; r += lgdim() * 512) rs[r] = slot_rs(slots, r); }
__device__ __forceinline__ void prep0_phase(const float* xin, const float* g, bf16_t* xg, float* rs, const int wv) {
    const int tid = ltid(wv), lane = tid & 63, wave = tid >> 6;
    f32x4 gv[4];
#pragma unroll
    for (int i = 0; i < 4; ++i) gv[i] = *(const f32x4*)(g + i * 256 + lane * 4);
    for (int row = lbid() * 8 + wave; row < NTOK; row += lgdim() * 8) {
        const float* xr = xin + (size_t)row * DM; f32x4 v[4]; float s = 0.f;
#pragma unroll
        for (int i = 0; i < 4; ++i) { v[i] = *(const f32x4*)(xr + i * 256 + lane * 4); s += v[i][0] * v[i][0] + v[i][1] * v[i][1] + v[i][2] * v[i][2] + v[i][3] * v[i][3]; }
        s = wave_sum(s, lane);
        if (lane == 0) rs[row] = __builtin_amdgcn_rsqf(s * (1.0f / DM) + EPS);
#pragma unroll
        for (int i = 0; i < 4; ++i) { u32x2 w; w.x = pk2(v[i][0] * gv[i][0], v[i][1] * gv[i][1]); w.y = pk2(v[i][2] * gv[i][2], v[i][3] * gv[i][3]);
            *(u32x2*)(xg + (size_t)row * DM + i * 256 + lane * 4) = w; }
    }
}
__device__ __forceinline__ void final_norm_phase(float* x, const float* g, const float* slots, const int wv) {
    const int tid = ltid(wv), lane = tid & 63, wave = tid >> 6;
    f32x4 gv[4];
#pragma unroll
    for (int i = 0; i < 4; ++i) gv[i] = *(const f32x4*)(g + i * 256 + lane * 4);
    for (int row = lbid() * 8 + wave; row < NTOK; row += lgdim() * 8) {
        float* xr = x + (size_t)row * DM; const float rs = slot_rs(slots, row);
#pragma unroll
        for (int i = 0; i < 4; ++i) { const f32x4 v = *(const f32x4*)(xr + i * 256 + lane * 4); *(f32x4*)(xr + i * 256 + lane * 4) = v * rs * gv[i]; }
    }
}

template <class Map>
__device__ __forceinline__ void conv_issue(const float* src, int Nsrc, int ntn, int t, int tid, Map map, float (&r)[8]) {
    const int tn = t % ntn, tk = t / ntn;
#pragma unroll
    for (int it = 0; it < 8; ++it) { const int idx = it * 512 + tid, kk = idx >> 6, nn = idx & 63; const int col = map(tn * 64 + nn);
        r[it] = col >= 0 ? src[(size_t)(tk * 64 + kk) * Nsrc + col] : 0.f; }
}
template <class Map>
__device__ __forceinline__ void conv_T(LAS unsigned char* lds, const float* src, int K, int Nsrc, bf16_t* dst, int Ndst, Map map, const int wv) {
    LAS float* tile = (LAS float*)lds;
    const int tid = ltid(wv), ntn = Ndst / 64, ntiles = ntn * (K / 64), G = lgdim();
    float cur[8], nx1[8], nx2[8];
    int t = lbid();
    if (t < ntiles) conv_issue(src, Nsrc, ntn, t, tid, map, cur);
    if (t + G < ntiles) conv_issue(src, Nsrc, ntn, t + G, tid, map, nx1);
    for (; t < ntiles; t += G) {
        if (t + 2 * G < ntiles) conv_issue(src, Nsrc, ntn, t + 2 * G, tid, map, nx2);
        const int tn = t % ntn, tk = t / ntn;
#pragma unroll
        for (int it = 0; it < 8; ++it) { const int idx = it * 512 + tid, kk = idx >> 6, nn = idx & 63; tile[nn * 65 + kk] = cur[it]; }
        asm volatile("s_waitcnt lgkmcnt(0)\n\ts_barrier" ::: "memory");
        { const int nn = tid >> 3, sg = tid & 7; LAS const float* tp = tile + nn * 65 + sg * 8;
          u32x4 w; w.x = pk2(tp[0], tp[1]); w.y = pk2(tp[2], tp[3]); w.z = pk2(tp[4], tp[5]); w.w = pk2(tp[6], tp[7]);
          *(u32x4*)(dst + (size_t)(tn * 64 + nn) * K + tk * 64 + sg * 8) = w; }
        asm volatile("s_waitcnt lgkmcnt(0)\n\ts_barrier" ::: "memory");
#pragma unroll
        for (int it = 0; it < 8; ++it) { cur[it] = nx1[it]; nx1[it] = nx2[it]; }
    }
}
struct MapId { __device__ __forceinline__ int operator()(int n) const { return n; } };
struct MapZ { __device__ __forceinline__ int operator()(int n) const { return n < 2304 ? n : (n < 2816 ? n + 16 : (n < 2832 ? n - 512 : -1)); } };
struct MapGLU { __device__ __forceinline__ int operator()(int n) const { const int pn = n >> 8, bj = (n >> 7) & 1, i = n & 127; return bj * 1024 + pn * 128 + i; } };

__device__ __forceinline__ void s5_prep(LAS unsigned char* lds, const S5In p, int l, int unit, bf16_t* T1t, bf16_t* T2t, const int wv) {
    const int tid = ltid(wv), g = unit >> 4, c = unit & 15;
    LAS f32x2* Lpow = (LAS f32x2*)lds;
    LAS f32x2* Bb = (LAS f32x2*)(lds + 66560);
    LAS f32x2* Wm = (LAS f32x2*)(lds + 66560 + 16384);
    LAS float* Kt = (LAS float*)(lds + 66560 + 32768);
    const float* lam_re = p.lam_re + (size_t)l * 2048; const float* lam_im = p.lam_im + (size_t)l * 2048; const float* log_dt = p.log_dt + (size_t)l * 32;
    const float* b_re = p.b_re + (size_t)l * 32768; const float* b_im = p.b_im + (size_t)l * 32768;
    const float* c_re = p.c_re + (size_t)l * 32768; const float* c_im = p.c_im + (size_t)l * 32768;
    {
        const int dp = tid >> 2, dir = dp >> 6, pp = dp & 63, q4 = tid & 3;
        const float lr = lam_re[(dir * 16 + g) * 64 + pp], li = lam_im[(dir * 16 + g) * 64 + pp], dt = __expf(log_dt[dir * 16 + g]);
        for (int tau = q4; tau <= 64; tau += 4) { const float mag = __expf(lr * dt * (float)tau); float s, cs; sincos_turns((double)li * (double)dt * (double)tau * INV2PI, s, cs);
            Lpow[(dir * 64 + pp) * 65 + tau] = (f32x2){mag * cs, mag * s}; }
        const float mag1 = __expf(lr * dt); float s1, c1; sincos_turns((double)li * (double)dt * INV2PI, s1, c1);
        const float nr = mag1 * c1 - 1.0f, ni = mag1 * s1, den = 1.0f / (lr * lr + li * li);
        const float rr = (nr * lr + ni * li) * den, ri = (ni * lr - nr * li) * den;
#pragma unroll
        for (int e = 0; e < 4; ++e) { const int cp = q4 * 4 + e; const float br = b_re[((dir * 16 + g) * 64 + pp) * 16 + cp], bi = b_im[((dir * 16 + g) * 64 + pp) * 16 + cp];
            Bb[(dir * 64 + pp) * 16 + cp] = (f32x2){rr * br - ri * bi, rr * bi + ri * br}; }
    }
    __syncthreads();
#pragma unroll
    for (int k = 0; k < 4; ++k) { const int idx = tid + 512 * k, dir = idx >> 10, pp = (idx >> 4) & 63;
        const float cr = c_re[((dir * 16 + g) * 16 + c) * 64 + pp], ci = c_im[((dir * 16 + g) * 16 + c) * 64 + pp]; const f32x2 b = Bb[idx];
        Wm[idx] = (f32x2){cr * b.x - ci * b.y, cr * b.y + ci * b.x}; }
    __syncthreads();
#pragma unroll
    for (int k = 0; k < 4; ++k) { const int idx = tid + 512 * k, dir = idx >> 10, tau = (idx >> 4) & 63, cp = idx & 15; float s = 0.f;
        for (int pp = 0; pp < 64; ++pp) { const f32x2 w = Wm[(dir * 64 + pp) * 16 + cp], L = Lpow[(dir * 64 + pp) * 65 + tau]; s += w.x * L.x - w.y * L.y; }
        Kt[idx] = s; }
    __syncthreads();
    const float Dv = p.d[l * 256 + g * 16 + c];
    for (int k = 0; k < 20; ++k) { const int seg = tid + 512 * k, t = seg / 160, sk = seg - t * 160; float v[8];
        if (sk < 128) { const int s = sk >> 1, c0 = (sk & 1) * 8;
#pragma unroll
            for (int e = 0; e < 8; ++e) { const int cp = c0 + e; float a = 0.f; if (t >= s) a += Kt[(t - s) * 16 + cp]; if (s >= t) a += Kt[1024 + (s - t) * 16 + cp]; if (s == t && cp == c) a += Dv; v[e] = a; } }
        else { const int kk = (sk - 128) * 8, which = kk >> 6, p0 = kk & 63, dir = which >> 1, im = which & 1, tau = dir == 0 ? t + 1 : 64 - t;
#pragma unroll
            for (int e = 0; e < 8; ++e) { const int pp = p0 + e; const float cr = c_re[((dir * 16 + g) * 16 + c) * 64 + pp], ci = c_im[((dir * 16 + g) * 16 + c) * 64 + pp]; const f32x2 L = Lpow[(dir * 64 + pp) * 65 + tau];
                v[e] = im ? -(cr * L.y + ci * L.x) : (cr * L.x - ci * L.y); } }
        u32x4 w; w.x = pk2(v[0], v[1]); w.y = pk2(v[2], v[3]); w.z = pk2(v[4], v[5]); w.w = pk2(v[6], v[7]);
        *(u32x4*)(T2t + ((size_t)g * 1024 + t * 16 + c) * 1280 + sk * 8) = w; }
#pragma unroll
    for (int k = 0; k < 4; ++k) { const int seg = tid + 512 * k, rr = seg >> 7, sk = seg & 127, dir = rr >> 3, ri = (rr >> 2) & 1, pp = 4 * c + (rr & 3), s = sk >> 1, c0 = (sk & 1) * 8;
        const f32x2 L = Lpow[(dir * 64 + pp) * 65 + (dir == 0 ? 63 - s : s)]; float v[8];
#pragma unroll
        for (int e = 0; e < 8; ++e) { const f32x2 b = Bb[(dir * 64 + pp) * 16 + c0 + e]; v[e] = ri ? (L.x * b.y + L.y * b.x) : (L.x * b.x - L.y * b.y); }
        u32x4 w; w.x = pk2(v[0], v[1]); w.y = pk2(v[2], v[3]); w.z = pk2(v[4], v[5]); w.w = pk2(v[6], v[7]);
        *(u32x4*)(T1t + ((size_t)g * 256 + dir * 128 + ri * 64 + pp) * 1024 + sk * 8) = w; }
    __syncthreads();
}
constexpr int L_BF = 0, L_BB = 16640, L_QIN = 33280, L_KIN = 42496, L_P = 51712, L_VT = 60928, L_ST = 79360, L_LR = 97792  , L_WG = 102912  ,
              L_BG = 113152  , L_TOT = 113664, L_NG = 117760  ;
constexpr int GS = 40;
constexpr int RS = 72;
template <int DV, bool GATED> struct Bla {
    const bf16_t* z; const bf16_t* zl; const float* wg; const float* bg; bf16_t* st; float* dec; const float* ng; bf16_t* out; int ldo;
};
__device__ __forceinline__ void lds_barrier() { asm volatile("s_waitcnt lgkmcnt(0)\n\ts_barrier" ::: "memory"); }
__device__ __forceinline__ bf16x8 frag(LAS const bf16_t* base, int row0, int kb, int lane) { return *(LAS const bf16x8*)(base + (row0 + (lane & 15)) * RS + kb * 32 + (lane >> 4) * 8); }
__device__ __forceinline__ void unpack4(u32x2 w, float* o) { o[0] = bf2f(w.x & 0xffffu); o[1] = bf2f(w.x >> 16); o[2] = bf2f(w.y & 0xffffu); o[3] = bf2f(w.y >> 16); }

template <int DV, bool GATED, bool S2> struct BlaRegs { u32x2 k0, k1, q0, q1; u32x4 lrf; u32x4 v[DV / 64]; u32x4 st[2][DV / 64]; u32x4 og[DV / 64]; };
template <int DV, bool GATED, bool S2>
__device__ __forceinline__ void bla_issue(const Bla<DV, GATED>& P, int unit, int tid, BlaRegs<DV, GATED, S2>& R) {
    const int b = unit >> 8, n = (unit >> 2) & 63, h = unit & 3, j = tid >> 3, sg = tid & 7; const int tok0 = b * SEQ + n * 64;
    constexpr int ROW = 128 + 2 * DV;
    const bf16_t* zr = P.z + ((size_t)((b * 64 + n) * 4 + h) * 64 + j) * ROW;
    R.k0 = *(const u32x2*)(zr + 64 + sg * 4); R.k1 = *(const u32x2*)(zr + 64 + 32 + sg * 4);
    if (S2) { R.q0 = *(const u32x2*)(zr + sg * 4); R.q1 = *(const u32x2*)(zr + 32 + sg * 4); }
    constexpr int NV = DV / 8;
#pragma unroll
    for (int q = 0; q < NV / 8; ++q) R.v[q] = *(const u32x4*)(zr + 128 + sg * NV + q * 8);
    if (GATED) { const int lane = tid & 63, jt = (tid >> 6) & 3;
        R.lrf = (lane < 32) ? *(const u32x4*)(P.zl + (size_t)(tok0 + jt * 16 + (lane & 15)) * 16 + (lane >> 4) * 8) : (u32x4){0u, 0u, 0u, 0u}; }
    if (S2) {
#pragma unroll
        for (int dir = 0; dir < 2; ++dir) { const bf16_t* stb = P.st + ((size_t)((b * 4 + h) * 2 + dir) * 64 + n) * (DV * 64);
#pragma unroll
            for (int q = 0; q < DV / 64; ++q) { const int sgi = tid + 512 * q, e = sgi >> 3, d8 = (sgi & 7) * 8; R.st[dir][q] = *(const u32x4*)(stb + e * 64 + d8); } }
#pragma unroll
        for (int q = 0; q < NV / 8; ++q) R.og[q] = *(const u32x4*)(zr + 128 + DV + sg * NV + q * 8);
    }
}
template <int DV, bool GATED>
__device__ __forceinline__ void bla_head_consts(LAS unsigned char* lds, const Bla<DV, GATED>& P, int h, int tid) {
    LAS bf16_t* wgt = (LAS bf16_t*)(lds + L_WG); LAS bf16_t* lra = (LAS bf16_t*)(lds + L_LR); LAS float* bgs = (LAS float*)(lds + L_BG); LAS float* ngs = (LAS float*)(lds + L_NG);
    if (GATED) {
#pragma unroll
        for (int k = 0; k < 4; ++k) { const int idx = tid + 512 * k, dir = idx >> 10, r = (idx >> 6) & 15, d = idx & 63; wgt[(dir * 64 + d) * GS + r] = (bf16_t)f2bf(P.wg[(dir * 16 + r) * 256 + h * 64 + d]); }
#pragma unroll
        for (int k = 0; k < 4; ++k) { const int idx = tid + 512 * k, c = idx >> 4, r = 16 + (idx & 15); wgt[c * GS + r] = 0; }
        for (int idx = tid; idx < 1024; idx += 512) lra[(idx >> 4) * GS + 16 + (idx & 15)] = 0;
        if (tid < 128) bgs[tid] = P.bg[(tid >> 6) * 256 + h * 64 + (tid & 63)];
    }
    if (tid < DV) ngs[tid] = P.ng[h * DV + tid];
    lds_barrier();
}

template <int DV, bool GATED, bool S2>
__device__ __forceinline__ void bla_front(LAS unsigned char* lds, const BlaRegs<DV, GATED, S2>& R, int n, int h, int tid, float (&klo)[4], float (&khi)[4], float (&qlo)[4], float (&qhi)[4]) {
    const int j = tid >> 3, sg = tid & 7;
    LAS float* bf = (LAS float*)(lds + L_BF); LAS float* bb = (LAS float*)(lds + L_BB); LAS bf16_t* vT = (LAS bf16_t*)(lds + L_VT);
    unpack4(R.k0, klo); unpack4(R.k1, khi);
    if (S2) { unpack4(R.q0, qlo); unpack4(R.q1, qhi);
#pragma unroll
        for (int e = 0; e < 4; ++e) { qlo[e] *= 0.125f; qhi[e] *= 0.125f; } }
    if (!GATED) {
        const float pos = (float)(n * 64 + j);
#pragma unroll
        for (int e = 0; e < 4; ++e) { const int i = sg * 4 + e; const float inv = __builtin_amdgcn_exp2f(-(float)i * (13.287712379549449f / 32.0f)); float s, c; sincos_turns((double)pos * (double)inv * INV2PI, s, c);
            const float a = klo[e], bq = khi[e]; klo[e] = a * c - bq * s; khi[e] = a * s + bq * c;
            if (S2) { const float a2 = qlo[e], b2 = qhi[e]; qlo[e] = a2 * c - b2 * s; qhi[e] = a2 * s + b2 * c; } }
    }
    if (S2) {
        constexpr int NV = DV / 8;
#pragma unroll
        for (int q = 0; q < NV / 8; ++q) { const u32x4 w = R.v[q]; const int e0 = sg * NV + q * 8;
            vT[(e0 + 0) * RS + j] = (bf16_t)(w.x & 0xffffu); vT[(e0 + 1) * RS + j] = (bf16_t)(w.x >> 16); vT[(e0 + 2) * RS + j] = (bf16_t)(w.y & 0xffffu); vT[(e0 + 3) * RS + j] = (bf16_t)(w.y >> 16);
            vT[(e0 + 4) * RS + j] = (bf16_t)(w.z & 0xffffu); vT[(e0 + 5) * RS + j] = (bf16_t)(w.z >> 16); vT[(e0 + 6) * RS + j] = (bf16_t)(w.w & 0xffffu); vT[(e0 + 7) * RS + j] = (bf16_t)(w.w >> 16); }
    } else {
        constexpr int NV = DV / 8, RSV = DV + 16;
#pragma unroll
        for (int q = 0; q < NV / 8; ++q) *(LAS u32x4*)(vT + j * RSV + sg * NV + q * 8) = R.v[q];
    }
    if (GATED) {
        LAS bf16_t* lra = (LAS bf16_t*)(lds + L_LR); LAS const bf16_t* wgt = (LAS const bf16_t*)(lds + L_WG); LAS const float* bgs = (LAS const float*)(lds + L_BG); LAS float* tot = (LAS float*)(lds + L_TOT);
        {
            const int lane = tid & 63, wave = tid >> 6; (void)lra;
            bf16x8 a; { const u32x4 w = R.lrf; a = __builtin_bit_cast(bf16x8, w); }
#pragma unroll
            for (int k = 0; k < 4; ++k) { const int t = wave + 8 * k, jt = t & 3, ct = t >> 2;
                const bf16x8 bq = *(LAS const bf16x8*)(wgt + (ct * 16 + (lane & 15)) * GS + (lane >> 4) * 8);
                f32x4 acc = {0.f, 0.f, 0.f, 0.f}; acc = __builtin_amdgcn_mfma_f32_16x16x32_bf16(a, bq, acc, 0, 0, 0);
                const int c = ct * 16 + (lane & 15); const float bias = bgs[c]; LAS float* dst = (c < 64 ? bf : bb) + (c & 63);
#pragma unroll
                for (int r = 0; r < 4; ++r) { const float x = acc[r] + bias; dst[(jt * 16 + (lane >> 4) * 4 + r) * 65] = (fminf(x, 0.f) - __logf(1.0f + __expf(-fabsf(x)))) * 0.0625f; } }
        }
        lds_barrier();
        {
            const int d = tid & 63, s8 = tid >> 6; float run = 0.f;
#pragma unroll
            for (int jj = 0; jj < 8; ++jj) { run += bf[(s8 * 8 + jj) * 65 + d]; bf[(s8 * 8 + jj) * 65 + d] = run; }
            tot[s8 * 64 + d] = run; run = 0.f;
#pragma unroll
            for (int jj = 7; jj >= 0; --jj) { run += bb[(s8 * 8 + jj) * 65 + d]; bb[(s8 * 8 + jj) * 65 + d] = run; }
            tot[512 + s8 * 64 + d] = run;
            lds_barrier();
            float of = 0.f, ob = 0.f;
#pragma unroll
            for (int s = 0; s < 8; ++s) { if (s < s8) of += tot[s * 64 + d]; if (s > s8) ob += tot[512 + s * 64 + d]; }
#pragma unroll
            for (int jj = 0; jj < 8; ++jj) { bf[(s8 * 8 + jj) * 65 + d] += of; bb[(s8 * 8 + jj) * 65 + d] += ob; }
        }
        lds_barrier();
    }
}

template <int DV, bool GATED>
__device__ __forceinline__ void bla_stage1(LAS unsigned char* lds, const Bla<DV, GATED>& P, int unit, const BlaRegs<DV, GATED, false>& R, int tid) {
    const int b = unit >> 8, n = (unit >> 2) & 63, h = unit & 3;
    const int lane = tid & 63, wave = tid >> 6, j = tid >> 3, sg = tid & 7;
    LAS float* bf = (LAS float*)(lds + L_BF); LAS float* bb = (LAS float*)(lds + L_BB); LAS bf16_t* vT = (LAS bf16_t*)(lds + L_VT);
    float klo[4], khi[4], qlo[4], qhi[4];
    bla_front<DV, GATED, false>(lds, R, n, h, tid, klo, khi, qlo, qhi);
    const float lgam = __logf(1.0f - __builtin_amdgcn_exp2f(-5.0f - (float)h)), cf = __expf((float)(63 - j) * lgam), cb = __expf((float)j * lgam);
    constexpr int KS = 80;
    LAS bf16_t* ksf = (LAS bf16_t*)(lds + L_QIN); LAS bf16_t* ksb = (LAS bf16_t*)(lds + L_QIN + 10240);
#pragma unroll
    for (int half = 0; half < 2; ++half) { float vf[4], vb[4];
#pragma unroll
        for (int e = 0; e < 4; ++e) { const int d = half * 32 + sg * 4 + e; const float kv = half ? khi[e] : klo[e];
            vf[e] = kv * (GATED ? __expf(bf[63 * 65 + d] - bf[j * 65 + d]) : cf); vb[e] = kv * (GATED ? __expf(bb[d] - bb[j * 65 + d]) : cb); }
        u32x2 wf, wb; wf.x = pk2(vf[0], vf[1]); wf.y = pk2(vf[2], vf[3]); wb.x = pk2(vb[0], vb[1]); wb.y = pk2(vb[2], vb[3]);
        *(LAS u32x2*)(ksf + j * KS + half * 32 + sg * 4) = wf; *(LAS u32x2*)(ksb + j * KS + half * 32 + sg * 4) = wb; }
    if (GATED && tid < 128) { const int dir = tid >> 6, d = tid & 63; P.dec[((size_t)((b * 4 + h) * 2 + dir) * 64 + n) * 64 + d] = __expf(dir ? bb[d] : bf[63 * 65 + d]); }
    lds_barrier();
    constexpr int NT = DV / 32, RSV = DV + 16;
    {
        const int g = lane >> 4, q = (lane & 15) >> 2, p = lane & 3, dt4 = wave & 3;
        const unsigned vaddr = (unsigned)(unsigned long long)(vT) + (unsigned)(((8 * g + q) * RSV + (wave >> 2) * 16 + 4 * p) * 2);
        const unsigned aaddr_f = (unsigned)(unsigned long long)(ksf) + (unsigned)(((8 * g + q) * KS + dt4 * 16 + 4 * p) * 2), aaddr_b = aaddr_f + 10240u;
        u32x2 bq[NT][2][2], af[2][2], ab[2][2];
        if constexpr (DV == 128) { asm volatile("ds_read_b64_tr_b16 %0, %20 offset:0\n\t" "ds_read_b64_tr_b16 %1, %20 offset:1152\n\t" "ds_read_b64_tr_b16 %2, %20 offset:9216\n\t" "ds_read_b64_tr_b16 %3, %20 offset:10368\n\t" "ds_read_b64_tr_b16 %4, %20 offset:64\n\t" "ds_read_b64_tr_b16 %5, %20 offset:1216\n\t" "ds_read_b64_tr_b16 %6, %20 offset:9280\n\t" "ds_read_b64_tr_b16 %7, %20 offset:10432\n\t" "ds_read_b64_tr_b16 %8, %20 offset:128\n\t" "ds_read_b64_tr_b16 %9, %20 offset:1280\n\t" "ds_read_b64_tr_b16 %10, %20 offset:9344\n\t" "ds_read_b64_tr_b16 %11, %20 offset:10496\n\t" "ds_read_b64_tr_b16 %12, %20 offset:192\n\t" "ds_read_b64_tr_b16 %13, %20 offset:1344\n\t" "ds_read_b64_tr_b16 %14, %20 offset:9408\n\t" "ds_read_b64_tr_b16 %15, %20 offset:10560\n\t" "ds_read_b64_tr_b16 %16, %21 offset:0\n\t" "ds_read_b64_tr_b16 %17, %21 offset:640\n\t" "ds_read_b64_tr_b16 %18, %21 offset:5120\n\t" "ds_read_b64_tr_b16 %19, %21 offset:5760\n\t" "s_waitcnt lgkmcnt(0)" : "=&v"(bq[0][0][0]), "=&v"(bq[0][0][1]), "=&v"(bq[0][1][0]), "=&v"(bq[0][1][1]), "=&v"(bq[1][0][0]), "=&v"(bq[1][0][1]), "=&v"(bq[1][1][0]), "=&v"(bq[1][1][1]), "=&v"(bq[2][0][0]), "=&v"(bq[2][0][1]), "=&v"(bq[2][1][0]), "=&v"(bq[2][1][1]), "=&v"(bq[3][0][0]), "=&v"(bq[3][0][1]), "=&v"(bq[3][1][0]), "=&v"(bq[3][1][1]), "=&v"(af[0][0]), "=&v"(af[0][1]), "=&v"(af[1][0]), "=&v"(af[1][1]) : "v"(vaddr), "v"(aaddr_f) : "memory");
            asm volatile("ds_read_b64_tr_b16 %0, %4 offset:0\n\t" "ds_read_b64_tr_b16 %1, %4 offset:640\n\t" "ds_read_b64_tr_b16 %2, %4 offset:5120\n\t" "ds_read_b64_tr_b16 %3, %4 offset:5760\n\t" "s_waitcnt lgkmcnt(0)" : "=&v"(ab[0][0]), "=&v"(ab[0][1]), "=&v"(ab[1][0]), "=&v"(ab[1][1]) : "v"(aaddr_b) : "memory"); }
        else { asm volatile("ds_read_b64_tr_b16 %0, %12 offset:0\n\t" "ds_read_b64_tr_b16 %1, %12 offset:640\n\t" "ds_read_b64_tr_b16 %2, %12 offset:5120\n\t" "ds_read_b64_tr_b16 %3, %12 offset:5760\n\t" "ds_read_b64_tr_b16 %4, %12 offset:64\n\t" "ds_read_b64_tr_b16 %5, %12 offset:704\n\t" "ds_read_b64_tr_b16 %6, %12 offset:5184\n\t" "ds_read_b64_tr_b16 %7, %12 offset:5824\n\t" "ds_read_b64_tr_b16 %8, %13 offset:0\n\t" "ds_read_b64_tr_b16 %9, %13 offset:640\n\t" "ds_read_b64_tr_b16 %10, %13 offset:5120\n\t" "ds_read_b64_tr_b16 %11, %13 offset:5760\n\t" "s_waitcnt lgkmcnt(0)" : "=&v"(bq[0][0][0]), "=&v"(bq[0][0][1]), "=&v"(bq[0][1][0]), "=&v"(bq[0][1][1]), "=&v"(bq[1][0][0]), "=&v"(bq[1][0][1]), "=&v"(bq[1][1][0]), "=&v"(bq[1][1][1]), "=&v"(af[0][0]), "=&v"(af[0][1]), "=&v"(af[1][0]), "=&v"(af[1][1]) : "v"(vaddr), "v"(aaddr_f) : "memory");
            asm volatile("ds_read_b64_tr_b16 %0, %4 offset:0\n\t" "ds_read_b64_tr_b16 %1, %4 offset:640\n\t" "ds_read_b64_tr_b16 %2, %4 offset:5120\n\t" "ds_read_b64_tr_b16 %3, %4 offset:5760\n\t" "s_waitcnt lgkmcnt(0)" : "=&v"(ab[0][0]), "=&v"(ab[0][1]), "=&v"(ab[1][0]), "=&v"(ab[1][1]) : "v"(aaddr_b) : "memory"); }
#pragma unroll
        for (int dir = 0; dir < 2; ++dir) {
            bf16_t* stb = P.st + ((size_t)((b * 4 + h) * 2 + dir) * 64 + n) * (DV * 64);
#pragma unroll
            for (int k = 0; k < NT; ++k) { const int et = (wave >> 2) + 2 * k; f32x4 acc = {0.f, 0.f, 0.f, 0.f};
#pragma unroll
                for (int kb = 0; kb < 2; ++kb) { const u32x2 a0 = dir ? ab[kb][0] : af[kb][0], a1 = dir ? ab[kb][1] : af[kb][1];
                    const u32x4 aw = {a0.x, a0.y, a1.x, a1.y}, bw = {bq[k][kb][0].x, bq[k][kb][0].y, bq[k][kb][1].x, bq[k][kb][1].y};
                    acc = __builtin_amdgcn_mfma_f32_16x16x32_bf16(__builtin_bit_cast(bf16x8, aw), __builtin_bit_cast(bf16x8, bw), acc, 0, 0, 0); }
                u32x2 w; w.x = pk2(acc[0], acc[1]); w.y = pk2(acc[2], acc[3]);
                *(u32x2*)(stb + (et * 16 + (lane & 15)) * 64 + dt4 * 16 + (lane >> 4) * 4) = w; }
        }
    }
    lds_barrier();
}

template <int DV, bool GATED>
__device__ __forceinline__ void bla_stage2(LAS unsigned char* lds, const Bla<DV, GATED>& P, int unit, const BlaRegs<DV, GATED, true>& R, int tid) {
    const int b = unit >> 8, n = (unit >> 2) & 63, h = unit & 3;
    const int lane = tid & 63, wave = tid >> 6, j = tid >> 3, sg = tid & 7; const int tok0 = b * SEQ + n * 64;
    LAS float* bf = (LAS float*)(lds + L_BF); LAS float* bb = (LAS float*)(lds + L_BB); LAS bf16_t* vT = (LAS bf16_t*)(lds + L_VT);
    LAS bf16_t* qin = (LAS bf16_t*)(lds + L_QIN); LAS bf16_t* kin = (LAS bf16_t*)(lds + L_KIN); LAS bf16_t* Pm = (LAS bf16_t*)(lds + L_P); LAS bf16_t* ST = (LAS bf16_t*)(lds + L_ST);
    float klo[4], khi[4], qlo[4], qhi[4];
    bla_front<DV, GATED, true>(lds, R, n, h, tid, klo, khi, qlo, qhi);
    const float lgam = __logf(1.0f - __builtin_amdgcn_exp2f(-5.0f - (float)h));
    constexpr int NT = DV / 32;
    f32x4 oacc[NT];
#pragma unroll
    for (int k = 0; k < NT; ++k) oacc[k] = (f32x4){0.f, 0.f, 0.f, 0.f};
#pragma unroll
    for (int dir = 0; dir < 2; ++dir) {
        LAS const float* bx = dir ? bb : bf;
        const float bret = (float)(dir ? 64 - j : j + 1) * lgam, eq = __expf(bret), ek = __expf(-bret);
#pragma unroll
        for (int half = 0; half < 2; ++half) { float qv[4], kv4[4];
#pragma unroll
            for (int e = 0; e < 4; ++e) { const int d = half * 32 + sg * 4 + e;
                if (GATED) { const float bv = bx[j * 65 + d]; qv[e] = (half ? qhi[e] : qlo[e]) * __expf(bv); kv4[e] = (half ? khi[e] : klo[e]) * __expf(-bv); }
                else { qv[e] = (half ? qhi[e] : qlo[e]) * eq; kv4[e] = (half ? khi[e] : klo[e]) * ek; } }
            u32x2 wq, wk; wq.x = pk2(qv[0], qv[1]); wq.y = pk2(qv[2], qv[3]); wk.x = pk2(kv4[0], kv4[1]); wk.y = pk2(kv4[2], kv4[3]);
            *(LAS u32x2*)(qin + j * RS + half * 32 + sg * 4) = wq; *(LAS u32x2*)(kin + j * RS + half * 32 + sg * 4) = wk; }
#pragma unroll
        for (int q = 0; q < DV / 64; ++q) { const int sgi = tid + 512 * q, e = sgi >> 3, d8 = (sgi & 7) * 8; *(LAS u32x4*)(ST + e * RS + d8) = R.st[dir][q]; }
        lds_barrier();
#pragma unroll
        for (int k = 0; k < 2; ++k) { const int t = wave + 8 * k, it = t & 3, jt = t >> 2; f32x4 acc = {0.f, 0.f, 0.f, 0.f};
#pragma unroll
            for (int kb = 0; kb < 2; ++kb) acc = __builtin_amdgcn_mfma_f32_16x16x32_bf16(frag(qin, it * 16, kb, lane), frag(kin, jt * 16, kb, lane), acc, 0, 0, 0);
            const int jj = jt * 16 + (lane & 15);
#pragma unroll
            for (int r = 0; r < 4; ++r) { const int ii = it * 16 + (lane >> 4) * 4 + r; const bool keep = dir ? (jj > ii) : (jj <= ii); Pm[ii * RS + jj] = (bf16_t)f2bf(keep ? acc[r] : 0.f); } }
        lds_barrier();
#pragma unroll
        for (int k = 0; k < NT; ++k) { const int t = wave + 8 * k, it = t & 3, et = t >> 2;
#pragma unroll
            for (int kb = 0; kb < 2; ++kb) oacc[k] = __builtin_amdgcn_mfma_f32_16x16x32_bf16(frag(Pm, it * 16, kb, lane), frag(vT, et * 16, kb, lane), oacc[k], 0, 0, 0);
#pragma unroll
            for (int kb = 0; kb < 2; ++kb) oacc[k] = __builtin_amdgcn_mfma_f32_16x16x32_bf16(frag(qin, it * 16, kb, lane), frag(ST, et * 16, kb, lane), oacc[k], 0, 0, 0); }
        lds_barrier();
    }
    constexpr int OS = DV + 4; LAS float* ob = (LAS float*)lds; LAS const float* ngs = (LAS const float*)(lds + L_NG);
#pragma unroll
    for (int k = 0; k < NT; ++k) { const int t = wave + 8 * k, it = t & 3, et = t >> 2;
#pragma unroll
        for (int r = 0; r < 4; ++r) ob[(it * 16 + (lane >> 4) * 4 + r) * OS + et * 16 + (lane & 15)] = oacc[k][r]; }
    lds_barrier();
    {
        constexpr int NV = DV / 8; float v[NV]; float s = 0.f;
#pragma unroll
        for (int e = 0; e < NV; ++e) { v[e] = ob[j * OS + sg * NV + e]; s += v[e]; }
        if (!GATED) { s += shx(s, 1, lane); s += shx(s, 2, lane); s += shx(s, 4, lane); const float mean = s * (1.0f / DV);
#pragma unroll
            for (int e = 0; e < NV; ++e) v[e] -= mean; }
        float q = 0.f;
#pragma unroll
        for (int e = 0; e < NV; ++e) q += v[e] * v[e];
        q += shx(q, 1, lane); q += shx(q, 2, lane); q += shx(q, 4, lane);
        const float rs = __builtin_amdgcn_rsqf(q * (1.0f / DV) + EPS);
        bf16_t* op = P.out + (size_t)(tok0 + j) * P.ldo + h * DV + sg * NV;
#pragma unroll
        for (int q8 = 0; q8 < NV / 8; ++q8) { const u32x4 gw = R.og[q8]; float gt[8];
            gt[0] = bf2f(gw.x & 0xffffu); gt[1] = bf2f(gw.x >> 16); gt[2] = bf2f(gw.y & 0xffffu); gt[3] = bf2f(gw.y >> 16); gt[4] = bf2f(gw.z & 0xffffu); gt[5] = bf2f(gw.z >> 16); gt[6] = bf2f(gw.w & 0xffffu); gt[7] = bf2f(gw.w >> 16);
            float r[8];
#pragma unroll
            for (int e = 0; e < 8; ++e) { const float y = v[q8 * 8 + e] * rs * ngs[sg * NV + q8 * 8 + e]; r[e] = y * gt[e] * sigmoidf_(gt[e]); }
            u32x4 w; w.x = pk2(r[0], r[1]); w.y = pk2(r[2], r[3]); w.z = pk2(r[4], r[5]); w.w = pk2(r[6], r[7]);
            *(u32x4*)(op + q8 * 8) = w; }
    }
    lds_barrier();
}
template <int DV, bool GATED>
__device__ __forceinline__ void bla_phase1(LAS unsigned char* lds, const Bla<DV, GATED>& P, const int wv) {
    const int tid = ltid(wv), G = lgdim(); int u = lbid(), hl = -1;
    BlaRegs<DV, GATED, false> cur, nx1, nx2;
    if (u < 4096) bla_issue<DV, GATED, false>(P, u, tid, cur);
    if (u + G < 4096) bla_issue<DV, GATED, false>(P, u + G, tid, nx1);
    for (; u < 4096; u += G) {
        if (u + 2 * G < 4096) bla_issue<DV, GATED, false>(P, u + 2 * G, tid, nx2);
        if ((u & 3) != hl) { hl = u & 3; bla_head_consts<DV, GATED>(lds, P, hl, tid); }
        bla_stage1<DV, GATED>(lds, P, u, cur, tid);
        cur = nx1; nx1 = nx2;
    }
}
template <int DV, bool GATED>
__device__ __forceinline__ void bla_phase2(LAS unsigned char* lds, const Bla<DV, GATED>& P, const int wv) {
    const int tid = ltid(wv), G = lgdim(); int u = lbid(), hl = -1;
    BlaRegs<DV, GATED, true> cur, nx1, nx2;
    if (u < 4096) bla_issue<DV, GATED, true>(P, u, tid, cur);
    if (u + G < 4096) bla_issue<DV, GATED, true>(P, u + G, tid, nx1);
    for (; u < 4096; u += G) {
        if (u + 2 * G < 4096) bla_issue<DV, GATED, true>(P, u + 2 * G, tid, nx2);
        if ((u & 3) != hl) { hl = u & 3; bla_head_consts<DV, GATED>(lds, P, hl, tid); }
        bla_stage2<DV, GATED>(lds, P, u, cur, tid);
        cur = nx1; nx1 = nx2;
    }
}

__device__ __forceinline__ void bla_scan_pair(int gi, int ri, int si, bf16_t* gst, const float* gdec, bf16_t* rst, const S5In p, int l, const float* Xl, bf16_t* Uc) {
    const int gd8 = gi & 7, ge = (gi >> 3) & 127, gbhd = gi >> 10, gdir = gbhd & 1;
    bf16_t* gbase = gst + (size_t)gbhd * 64 * 128 * 64 + ge * 64 + gd8 * 8; const float* dbase = gdec + (size_t)gbhd * 64 * 64 + gd8 * 8;
    const bool hasr = ri >= 0; const int rr = hasr ? ri : 0;
    const int rd8 = rr & 7, re = (rr >> 3) & 63, rbhd = rr >> 9, rdir = rbhd & 1, rh = (rbhd >> 1) & 3;
    bf16_t* rbase = rst + (size_t)rbhd * 64 * 64 * 64 + re * 64 + rd8 * 8;
    const float cdec = __expf(64.0f * __logf(1.0f - __builtin_amdgcn_exp2f(-5.0f - (float)rh)));
    float S[8], T[8];
#pragma unroll
    for (int k = 0; k < 8; ++k) { S[k] = 0.f; T[k] = 0.f; }
    const bool hass = si >= 0; const int sx = hass ? si : 0;
    const int spp = sx & 63, sdir = (sx >> 6) & 1, sg5 = (sx >> 7) & 15, sb = sx >> 11;
    float Lr = 0.f, Li = 0.f, xr = 0.f, xi = 0.f;
    if (hass) { const float lr = p.lam_re[(size_t)l * 2048 + (sdir * 16 + sg5) * 64 + spp], li = p.lam_im[(size_t)l * 2048 + (sdir * 16 + sg5) * 64 + spp], dt = __expf(p.log_dt[l * 32 + sdir * 16 + sg5]);
        const float mag = __expf(lr * dt * 64.f); float sn, cs; sincos_turns((double)li * (double)dt * 64.0 * INV2PI, sn, cs); Lr = mag * cs; Li = mag * sn; }
    const size_t srow0 = (size_t)sg5 * 1024 + sb * 64;
#pragma unroll 1
    for (int bt = 0; bt < 8; ++bt) {
        u32x4 kw[8], rw[8]; f32x4 d0[8], d1[8];
#pragma unroll
        for (int s = 0; s < 8; ++s) { const int stp = bt * 8 + s, n = gdir ? 63 - stp : stp, nr = rdir ? 63 - stp : stp;
            kw[s] = *(const u32x4*)(gbase + (size_t)n * 8192); d0[s] = *(const f32x4*)(dbase + n * 64); d1[s] = *(const f32x4*)(dbase + n * 64 + 4);
            rw[s] = hasr ? *(const u32x4*)(rbase + (size_t)nr * 4096) : (u32x4){0u, 0u, 0u, 0u}; }
        float ar[8], ai[8];
#pragma unroll
        for (int s = 0; s < 8; ++s) { const int stp = bt * 8 + s, n5 = sdir ? 63 - stp : stp; ar[s] = hass ? Xl[(srow0 + n5) * 256 + sdir * 128 + spp] : 0.f; ai[s] = hass ? Xl[(srow0 + n5) * 256 + sdir * 128 + 64 + spp] : 0.f; }
#pragma unroll
        for (int s = 0; s < 8; ++s) { const int stp = bt * 8 + s, n = gdir ? 63 - stp : stp, nr = rdir ? 63 - stp : stp;
            { u32x4 w; w.x = pk2(S[0], S[1]); w.y = pk2(S[2], S[3]); w.z = pk2(S[4], S[5]); w.w = pk2(S[6], S[7]); *(u32x4*)(gbase + (size_t)n * 8192) = w; }
            const u32x4 k4 = kw[s];
            S[0] = d0[s][0] * S[0] + bf2f(k4.x & 0xffffu); S[1] = d0[s][1] * S[1] + bf2f(k4.x >> 16); S[2] = d0[s][2] * S[2] + bf2f(k4.y & 0xffffu); S[3] = d0[s][3] * S[3] + bf2f(k4.y >> 16);
            S[4] = d1[s][0] * S[4] + bf2f(k4.z & 0xffffu); S[5] = d1[s][1] * S[5] + bf2f(k4.z >> 16); S[6] = d1[s][2] * S[6] + bf2f(k4.w & 0xffffu); S[7] = d1[s][3] * S[7] + bf2f(k4.w >> 16);
            if (hasr) { u32x4 w; w.x = pk2(T[0], T[1]); w.y = pk2(T[2], T[3]); w.z = pk2(T[4], T[5]); w.w = pk2(T[6], T[7]); *(u32x4*)(rbase + (size_t)nr * 4096) = w;
                const u32x4 r4 = rw[s];
                T[0] = cdec * T[0] + bf2f(r4.x & 0xffffu); T[1] = cdec * T[1] + bf2f(r4.x >> 16); T[2] = cdec * T[2] + bf2f(r4.y & 0xffffu); T[3] = cdec * T[3] + bf2f(r4.y >> 16);
                T[4] = cdec * T[4] + bf2f(r4.z & 0xffffu); T[5] = cdec * T[5] + bf2f(r4.z >> 16); T[6] = cdec * T[6] + bf2f(r4.w & 0xffffu); T[7] = cdec * T[7] + bf2f(r4.w >> 16); }
            if (hass) { const int n5 = sdir ? 63 - stp : stp;
                Uc[(srow0 + n5) * 1280 + 1024 + sdir * 128 + spp] = (bf16_t)f2bf(xr); Uc[(srow0 + n5) * 1280 + 1024 + sdir * 128 + 64 + spp] = (bf16_t)f2bf(xi);
                const float nr2 = Lr * xr - Li * xi + ar[s], ni2 = Lr * xi + Li * xr + ai[s]; xr = nr2; xi = ni2; } }
    }
}
__device__ __forceinline__ void s5_scan_item(const S5In p, int l, int idx, const float* Xl, bf16_t* Uc) {
    const int pp = idx & 63, dir = (idx >> 6) & 1, g = (idx >> 7) & 15, b = idx >> 11;
    const float lr = p.lam_re[(size_t)l * 2048 + (dir * 16 + g) * 64 + pp], li = p.lam_im[(size_t)l * 2048 + (dir * 16 + g) * 64 + pp], dt = __expf(p.log_dt[l * 32 + dir * 16 + g]);
    const float mag = __expf(lr * dt * 64.f); float s, cs; sincos_turns((double)li * (double)dt * 64.0 * INV2PI, s, cs);
    const float Lr = mag * cs, Li = mag * s; float xr = 0.f, xi = 0.f;
    const size_t row0 = (size_t)g * 1024 + b * 64;
#pragma unroll 1
    for (int bt = 0; bt < 4; ++bt) { float ar[16], ai[16];
#pragma unroll
        for (int q = 0; q < 16; ++q) { const int st = bt * 16 + q, n = dir ? 63 - st : st; ar[q] = Xl[(row0 + n) * 256 + dir * 128 + pp]; ai[q] = Xl[(row0 + n) * 256 + dir * 128 + 64 + pp]; }
#pragma unroll
        for (int q = 0; q < 16; ++q) { const int st = bt * 16 + q, n = dir ? 63 - st : st;
            Uc[(row0 + n) * 1280 + 1024 + dir * 128 + pp] = (bf16_t)f2bf(xr); Uc[(row0 + n) * 1280 + 1024 + dir * 128 + 64 + pp] = (bf16_t)f2bf(xi);
            const float nr = Lr * xr - Li * xi + ar[q], ni = Lr * xi + Li * xr + ai[q]; xr = nr; xi = ni; } }
}
__device__ __forceinline__ void scan_phase(const S5In p, int l, const float* Xl, bf16_t* Uc, bf16_t* gst, const float* gdec, bf16_t* rst, const int wv) {
    const int tid = ltid(wv), G = lgdim(), blk = lbid();
    for (int base = blk; base < 256; base += G) {
        const int gi = base * 512 + tid, ri = tid < 256 ? base * 256 + tid : -1;
        bla_scan_pair(gi, ri, tid >= 384 ? base * 128 + (tid - 384) : -1, gst, gdec, rst, p, l, Xl, Uc);
    }
}

typedef const Params __attribute__((address_space(4)))* PP;
__device__ __forceinline__ PP fresh_params() {
    unsigned long long ka = (unsigned long long)__builtin_amdgcn_kernarg_segment_ptr();
    asm volatile("" : "+s"(ka));
    return (PP)ka;
}
#define WSP(T, off) ((T*)(pp->ws + (off)))
#define XB_TMO      128
#define XB_XCNT(j)  (256  + 64 * (j))
#define XB_XSUB(j)  (1280 + 64 * (j))
#define XB_XGEN(j)  (2304 + 64 * (j))
#define XB_TOP      3328
#define XB_TOPGEN   3392
#define XCD_BAR_WORDS 3456
#define XB_SPIN_CAP (1u << 18)
__device__ __forceinline__ unsigned xb_ld(unsigned* p)              { return __hip_atomic_load(p, __ATOMIC_RELAXED, __HIP_MEMORY_SCOPE_AGENT); }
__device__ __forceinline__ unsigned xb_add(unsigned* p, unsigned v) { return __hip_atomic_fetch_add(p, v, __ATOMIC_RELAXED, __HIP_MEMORY_SCOPE_AGENT); }
__device__ __forceinline__ unsigned xb_xcc_id() { return (unsigned)__builtin_amdgcn_s_getreg((3 << 11) | 20) & 0xFu; }
#define XB_SPIN(cond, bar) do { unsigned _sp = 0; while (cond) { __builtin_amdgcn_s_sleep(1); \
    if ((++_sp & 255u) == 0u) { if (xb_ld(&(bar)[XB_TMO])) break; if (_sp > XB_SPIN_CAP) { atomicAdd(&(bar)[XB_TMO], 1u); break; } } } } while (0)
__device__ __forceinline__ void xcd_barrier_complete(unsigned* bar, unsigned x, unsigned G, unsigned& nloc, unsigned& nx) {
    unsigned sum, cnt, mine, sp = 0u;
    for (;;) {
        sum = 0u; cnt = 0u; mine = 0u;
#pragma unroll
        for (unsigned j = 0; j < 16; ++j) { const unsigned c = xb_ld(&bar[XB_XCNT(j)]); sum += c; cnt += (c > 0u) ? 1u : 0u; mine = (j == x) ? c : mine; }
        if (sum == G) break;
        __builtin_amdgcn_s_sleep(1);
        if ((++sp & 255u) == 0u) { if (xb_ld(&bar[XB_TMO])) break; if (sp > XB_SPIN_CAP) { atomicAdd(&bar[XB_TMO], 1u); break; } }
    }
    nloc = mine > 0u ? mine : 1u; nx = cnt > 0u ? cnt : 1u;
}
__device__ __forceinline__ void grid_barrier(unsigned* bar, volatile LAS unsigned* st, const int wv) {
    asm volatile("s_waitcnt vmcnt(0) lgkmcnt(0)" ::: "memory");
    __syncthreads();
    if (ltid(wv) == 0) {
        const unsigned x = xb_xcc_id();
        __builtin_amdgcn_s_waitcnt(0);
        unsigned nloc = st[0], nx = st[1];
        if (nloc == 0u) { xcd_barrier_complete(bar, x, (unsigned)lgdim(), nloc, nx); st[0] = nloc; st[1] = nx; }
        const unsigned old = xb_add(&bar[XB_XSUB(x)], 1u);
        const unsigned gen = old / nloc;
        if (old + 1u == (gen + 1u) * nloc) {
            __builtin_amdgcn_fence(__ATOMIC_RELEASE, "agent");
            asm volatile("s_waitcnt vmcnt(0)" ::: "memory");
            const unsigned og = xb_add(&bar[XB_TOP], 1u);
            const unsigned tg = og / nx;
            if (og + 1u == (tg + 1u) * nx) xb_add(&bar[XB_TOPGEN], 1u);
            else XB_SPIN(xb_ld(&bar[XB_TOPGEN]) == tg, bar);
            __builtin_amdgcn_fence(__ATOMIC_ACQUIRE, "agent");
            xb_add(&bar[XB_XGEN(x)], 1u);
            asm volatile("s_waitcnt vmcnt(0)" ::: "memory");
        } else {
            XB_SPIN(xb_ld(&bar[XB_XGEN(x)]) == gen, bar);
            __builtin_amdgcn_fence(__ATOMIC_ACQUIRE, "agent");
            asm volatile("s_waitcnt vmcnt(0)" ::: "memory");
        }
    }
    __syncthreads();
}
#define GSYNC(i) do { PP pq = fresh_params(); grid_barrier((unsigned*)(pq->ws + WS_CTL), (volatile LAS unsigned*)(lds + 131072), wv); } while (0)

__global__ void __launch_bounds__(512, 2) fwd_megakernel(Params p_unused) {
    extern __shared__ __attribute__((aligned(16))) unsigned char lds_raw[];
    LAS unsigned char* lds = (LAS unsigned char*)lds_raw;
    const int wv = __builtin_amdgcn_readfirstlane((int)(threadIdx.x >> 6));
    if (threadIdx.x < 4) ((volatile LAS unsigned*)(lds + 131072))[threadIdx.x] = 0u;
    if (blockIdx.x == 0) { PP pz = fresh_params(); unsigned* bz = (unsigned*)(pz->ws + WS_CTL);
        for (int i = threadIdx.x; i < XCD_BAR_WORDS; i += 512) __hip_atomic_store(bz + i, 0u, __ATOMIC_RELAXED, __HIP_MEMORY_SCOPE_AGENT); }
    cg::this_grid().sync();
    if (threadIdx.x == 0) { PP pz = fresh_params(); (void)xb_add((unsigned*)(pz->ws + WS_CTL) + XB_XCNT(xb_xcc_id()), 1u); }

#pragma unroll 1
    for (int l = 0; l < DEPTH; ++l) {
#if !defined(NO_CONV)
        { PP pp = fresh_params(); conv_T(lds, pp->in[2] + (size_t)l * DM * 2832, DM, 2832, WSP(bf16_t, WS_WZ), 3072, MapZ(), wv); }
        { PP pp = fresh_params(); conv_T(lds, pp->in[18] + (size_t)l * DM * 3072, DM, 3072, WSP(bf16_t, WS_WG), 3072, MapId(), wv); }
        { PP pp = fresh_params(); conv_T(lds, pp->in[15] + (size_t)l * 256 * DM, 256, DM, WSP(bf16_t, WS_WA), DM, MapId(), wv); }
        { PP pp = fresh_params(); conv_T(lds, pp->in[16] + (size_t)l * 256 * 2048, 256, 2048, WSP(bf16_t, WS_WB), 2048, MapGLU(), wv); }
        { PP pp = fresh_params(); conv_T(lds, pp->in[17] + (size_t)l * 512 * DM, 512, DM, WSP(bf16_t, WS_WC), DM, MapId(), wv); }
        { PP pp = fresh_params(); conv_T(lds, pp->in[20] + (size_t)l * DM * DM, DM, DM, WSP(bf16_t, WS_WO), DM, MapId(), wv); }
        { PP pp = fresh_params(); conv_T(lds, pp->in[22] + (size_t)l * DM * DFF, DM, DFF, WSP(bf16_t, WS_W1), DFF, MapId(), wv); }
        { PP pp = fresh_params(); conv_T(lds, pp->in[23] + (size_t)l * DFF * DM, DFF, DM, WSP(bf16_t, WS_W2), DM, MapId(), wv); }
#endif
#if !defined(NO_PREP)
        { PP pp = fresh_params(); const S5In si{pp->in[4], pp->in[5], pp->in[6], pp->in[7], pp->in[8], pp->in[9], pp->in[10], pp->in[11]}; for (int u = lbid(); u < 256; u += lgdim()) s5_prep(lds, si, l, u, WSP(bf16_t, WS_T1), WSP(bf16_t, WS_T2), wv); }
#endif
        { PP pp = fresh_params(); if (l == 0) prep0_phase(pp->in[0], pp->in[1], WSP(bf16_t, WS_H), WSP(float, WS_RS1), wv); else rs_phase(WSP(float, WS_SL1), WSP(float, WS_RS1), wv); }
        GSYNC(0);
        { PP pp = fresh_params(); pg8::OrderStd S; S.init(WSP(bf16_t, WS_H), DM, WSP(bf16_t, WS_WZ), DM, NTOK, 3072); pg8::EpiZ E{WSP(bf16_t, WS_Z), WSP(bf16_t, WS_UC), WSP(float, WS_RS1)}; pg8::gemm_phase(lds, S, E, DM, DM, DM, wv); }
        GSYNC(1);
        { PP pp = fresh_params(); pg8::OrderBatch S; S.init(WSP(bf16_t, WS_UC), 1280, (size_t)1024 * 1280 * 2, WSP(bf16_t, WS_T1), 1024, (size_t)256 * 1024 * 2, 4, 1); pg8::EpiXloc E{WSP(float, WS_XL)}; pg8::gemm_phase(lds, S, E, 1024, 1280, 1024, wv); }
#if !defined(NO_BLA1)
        { PP pp = fresh_params(); Bla<64, false> PA{WSP(bf16_t, WS_Z) + ZR_OFF, nullptr, nullptr, nullptr, WSP(bf16_t, WS_RST), nullptr, pp->in[3] + l * 256, WSP(bf16_t, WS_RO), 256};
          bla_phase1<64, false>(lds, PA, wv); }
        { PP pp = fresh_params(); Bla<128, true> PC{WSP(bf16_t, WS_Z) + ZG_OFF, WSP(bf16_t, WS_Z) + ZL_OFF, pp->in[12] + (size_t)l * 2 * 16 * 256, pp->in[13] + l * 512, WSP(bf16_t, WS_GST), WSP(float, WS_GDEC), pp->in[14] + l * 512, WSP(bf16_t, WS_GO), 512};
          bla_phase1<128, true>(lds, PC, wv); }
#endif
        GSYNC(2);
#if !defined(NO_SCAN)
        { PP pp = fresh_params(); const S5In si{pp->in[4], pp->in[5], pp->in[6], pp->in[7], pp->in[8], pp->in[9], pp->in[10], pp->in[11]}; scan_phase(si, l, WSP(float, WS_XL), WSP(bf16_t, WS_UC), WSP(bf16_t, WS_GST), WSP(float, WS_GDEC), WSP(bf16_t, WS_RST), wv); }
#endif
        GSYNC(3);
        { PP pp = fresh_params(); pg8::OrderBatch S; S.init(WSP(bf16_t, WS_UC), 1280, (size_t)1024 * 1280 * 2, WSP(bf16_t, WS_T2), 1280, (size_t)1024 * 1280 * 2, 4, 4); pg8::EpiS5Y E{WSP(bf16_t, WS_Y)}; pg8::gemm_phase(lds, S, E, 1280, 1280, 1280, wv); }
#if !defined(NO_BLA2)
        { PP pp = fresh_params(); Bla<64, false> PA{WSP(bf16_t, WS_Z) + ZR_OFF, nullptr, nullptr, nullptr, WSP(bf16_t, WS_RST), nullptr, pp->in[3] + l * 256, WSP(bf16_t, WS_RO), 256};
          bla_phase2<64, false>(lds, PA, wv); }
        { PP pp = fresh_params(); Bla<128, true> PC{WSP(bf16_t, WS_Z) + ZG_OFF, WSP(bf16_t, WS_Z) + ZL_OFF, pp->in[12] + (size_t)l * 2 * 16 * 256, pp->in[13] + l * 512, WSP(bf16_t, WS_GST), WSP(float, WS_GDEC), pp->in[14] + l * 512, WSP(bf16_t, WS_GO), 512};
          bla_phase2<128, true>(lds, PC, wv); }
#endif
        GSYNC(4);
        { PP pp = fresh_params(); pg8::OrderStd S; S.init(WSP(bf16_t, WS_RO), 256, WSP(bf16_t, WS_WA), 256, NTOK, DM); pg8::EpiBf16<0> E{WSP(bf16_t, WS_Z), DM, nullptr}; pg8::gemm_phase(lds, S, E, 256, 256, 256, wv); }
        { PP pp = fresh_params(); pg8::OrderStd S; S.init(WSP(bf16_t, WS_Y), 256, WSP(bf16_t, WS_WB), 256, NTOK, 2048); pg8::EpiGLU E{WSP(bf16_t, WS_Z) + (size_t)NTOK * DM}; pg8::gemm_phase(lds, S, E, 256, 256, 256, wv); }
        { PP pp = fresh_params(); pg8::OrderStd S; S.init(WSP(bf16_t, WS_GO), 512, WSP(bf16_t, WS_WC), 512, NTOK, DM); pg8::EpiBf16<0> E{WSP(bf16_t, WS_Z) + (size_t)2 * NTOK * DM, DM, nullptr}; pg8::gemm_phase(lds, S, E, 512, 512, 512, wv); }
        GSYNC(5);
        { PP pp = fresh_params(); pg8::OrderMerge S; S.init(WSP(bf16_t, WS_H), DM, WSP(bf16_t, WS_WG), DM, NTOK); pg8::EpiMerge E{WSP(bf16_t, WS_Z), WSP(bf16_t, WS_GST), pp->in[19] + (size_t)l * 3072, WSP(float, WS_RS1)}; pg8::gemm_phase(lds, S, E, DM, DM, DM, wv); }
        GSYNC(6);
        { PP pp = fresh_params(); pg8::OrderStd S; S.init(WSP(bf16_t, WS_GST), DM, WSP(bf16_t, WS_WO), DM, NTOK, DM); pg8::EpiResNorm E{l == 0 ? pp->in[0] : pp->out, pp->out, WSP(bf16_t, WS_H), pp->in[21] + l * DM, WSP(float, WS_SL2)}; pg8::gemm_phase(lds, S, E, DM, DM, DM, wv); }
        GSYNC(7);
        { PP pp = fresh_params(); rs_phase(WSP(float, WS_SL2), WSP(float, WS_RS2), wv); }
        GSYNC(8);
        { PP pp = fresh_params(); pg8::OrderStd S; S.init(WSP(bf16_t, WS_H), DM, WSP(bf16_t, WS_W1), DM, NTOK, DFF); pg8::EpiBf16<1> E{WSP(bf16_t, WS_Z), DFF, WSP(float, WS_RS2)}; pg8::gemm_phase(lds, S, E, DM, DM, DM, wv); }
        GSYNC(9);
        { PP pp = fresh_params(); pg8::OrderStd S; S.init(WSP(bf16_t, WS_Z), DFF, WSP(bf16_t, WS_W2), DFF, NTOK, DM); pg8::EpiResNorm E{pp->out, pp->out, l + 1 < DEPTH ? WSP(bf16_t, WS_H) : nullptr, pp->in[1] + (l + 1 < DEPTH ? (l + 1) * DM : 0), WSP(float, WS_SL1)}; pg8::gemm_phase(lds, S, E, DFF, DFF, DFF, wv); }
        GSYNC(10);
    }
    { PP pp = fresh_params(); final_norm_phase(pp->out, pp->in[24], WSP(float, WS_SL1), wv); }
}

extern "C" void kernel_launch(void* const* d_in, const int* in_sizes, int n_in, void* d_out, int out_size, void* d_ws, size_t ws_size, hipStream_t stream) {
    static int grid_blocks = 0;
    if (grid_blocks == 0) {
        if (n_in != 25 || out_size != NTOK * DM || ws_size < WS_END) { fprintf(stderr, "kernel_launch: unexpected shapes (n_in %d out %d ws %zu need %zu)\n", n_in, out_size, ws_size, (size_t)WS_END); grid_blocks = -1; return; }
        int dev = 0, cus = 0, per_cu = 0;
        (void)hipGetDevice(&dev);
        (void)hipDeviceGetAttribute(&cus, hipDeviceAttributeMultiprocessorCount, dev);
        (void)hipFuncSetAttribute((const void*)fwd_megakernel, hipFuncAttributeMaxDynamicSharedMemorySize, LDS_BYTES);
        (void)hipOccupancyMaxActiveBlocksPerMultiprocessor(&per_cu, (const void*)fwd_megakernel, 512, LDS_BYTES);
        if (per_cu < 1) { fprintf(stderr, "kernel_launch: occupancy query says %d blocks per CU\n", per_cu); per_cu = 1; }
        (void)hipGetLastError();
        grid_blocks = cus * per_cu;
        if (grid_blocks > 256) grid_blocks = 256;
    }
    if (grid_blocks < 0) return;
    Params p{};
    for (int i = 0; i < 25; ++i) p.in[i] = (const float*)d_in[i];
    p.out = (float*)d_out; p.ws = (unsigned char*)d_ws;
    void* args[] = {&p};
    hipError_t e = hipLaunchCooperativeKernel((const void*)fwd_megakernel, dim3(grid_blocks), dim3(512), args, LDS_BYTES, stream);
    if (e != hipSuccess) fprintf(stderr, "cooperative launch failed: %s (grid %d)\n", hipGetErrorString(e), grid_blocks);
}
```

```cpp
#include <hip/hip_runtime.h>
#include <hip/hip_cooperative_groups.h>
#include <cstdio>
#include <cstdint>
namespace cg = cooperative_groups;

#define LAS __attribute__((address_space(3)))
typedef unsigned short bf16_t;
typedef short bf16x8 __attribute__((ext_vector_type(8)));
typedef float f32x4 __attribute__((ext_vector_type(4)));
typedef float f32x2 __attribute__((ext_vector_type(2)));
typedef unsigned u32x4 __attribute__((ext_vector_type(4)));
typedef unsigned u32x2 __attribute__((ext_vector_type(2)));

#ifndef EN_A
#define EN_A 1
#endif
#ifndef EN_B
#define EN_B 1
#endif
#ifndef EN_C
#define EN_C 1
#endif

constexpr int NTOK = 65536, DM = 1024, SEQ = 4096, DEPTH = 4, DFF = 4096;
constexpr int ZS = 3072;
constexpr int C_RQ = 0, C_RK = 256, C_RV = 512, C_RG = 768, C_SU = 1024, C_GQ = 1280, C_GK = 1536, C_GV = 1792, C_GR = 2304, C_LR = 2816;
constexpr int LDS_BYTES = 131072 + 16;
constexpr size_t ZR_OFF = 0, ZG_OFF = (size_t)65536 * 1024, ZL_OFF = ZG_OFF + (size_t)65536 * 1536;
constexpr float EPS = 1e-6f;

constexpr size_t WS_WZ = 0;
constexpr size_t WS_WG = WS_WZ + 6291456;
constexpr size_t WS_WA = WS_WG + 6291456;
constexpr size_t WS_WB = WS_WA + 524288;
constexpr size_t WS_WC = WS_WB + 1048576;
constexpr size_t WS_WO = WS_WC + 1048576;
constexpr size_t WS_W1 = WS_WO + 2097152;
constexpr size_t WS_W2 = WS_W1 + 8388608;
constexpr size_t WS_T1 = WS_W2 + 8388608;
constexpr size_t WS_T2 = WS_T1 + 8388608;
constexpr size_t WS_UC = WS_T2 + 41943040;
constexpr size_t WS_XL = WS_UC + 41943040;
constexpr size_t WS_H  = WS_XL + 16777216;
constexpr size_t WS_Z  = WS_H + 134217728;
constexpr size_t WS_RO = WS_Z + 402653184;
constexpr size_t WS_Y  = WS_RO + 33554432;
constexpr size_t WS_GO = WS_Y + 33554432;
constexpr size_t WS_GST = WS_GO + 67108864;
constexpr size_t WS_RST = WS_GST + 134217728;
constexpr size_t WS_GDEC = WS_RST + 67108864;
constexpr size_t WS_CTL = WS_GDEC + 2097152;
constexpr size_t WS_SL1 = WS_CTL + 16384;
constexpr size_t WS_SL2 = WS_SL1 + 4194304;
constexpr size_t WS_RS1 = WS_SL2 + 4194304;
constexpr size_t WS_RS2 = WS_RS1 + 262144;
constexpr size_t WS_END = WS_RS2 + 262144;

struct Params { const float* in[25]; float* out; unsigned char* ws; };
struct S5In { const float *lam_re, *lam_im, *log_dt, *b_re, *b_im, *c_re, *c_im, *d; };

__device__ __forceinline__ float bf2f(unsigned b) { return __uint_as_float(b << 16); }
typedef __bf16 bf16v2_t __attribute__((ext_vector_type(2)));
__device__ __forceinline__ unsigned pk2(float lo, float hi) { const f32x2 v = {lo, hi}; const bf16v2_t b = __builtin_convertvector(v, bf16v2_t); return __builtin_bit_cast(unsigned, b); }
__device__ __forceinline__ unsigned f2bf(float f) { return pk2(f, f) & 0xffffu; }

__device__ __forceinline__ float sigmoidf_(float x) { return __builtin_amdgcn_rcpf(1.0f + __expf(-x)); }
__device__ __forceinline__ void sincos_turns(double turns, float& s, float& c) { turns -= rint(turns); const float t = (float)turns; s = __builtin_amdgcn_sinf(t); c = __builtin_amdgcn_cosf(t); }
__device__ __forceinline__ int ltid(int wv) { int lane; asm volatile("v_mbcnt_lo_u32_b32 %0, -1, 0\n\tv_mbcnt_hi_u32_b32 %0, -1, %0" : "=v"(lane)); return wv * 64 + lane; }
__device__ __forceinline__ int lbid() { int t = blockIdx.x; asm volatile("" : "+s"(t)); return t; }
__device__ __forceinline__ int lgdim() { int t = gridDim.x; asm volatile("" : "+s"(t)); return t; }
__device__ __forceinline__ float shx(float v, int mask, int lane) { return __int_as_float(__builtin_amdgcn_ds_bpermute((lane ^ mask) << 2, __float_as_int(v))); }
constexpr double INV2PI = 0.15915494309189533577;
__device__ __forceinline__ f32x2 gelu_pk(f32x2 v) {
    const f32x2 av = __builtin_elementwise_abs(v), d = av * 0.2316418882f + 1.0f;
    f32x2 t; t.x = __builtin_amdgcn_rcpf(d.x); t.y = __builtin_amdgcn_rcpf(d.y);
    f32x2 q = t * 0.5307027145f + (-0.7265760135f); q = q * t + 0.7107068705f; q = q * t + (-0.142248368f); q = q * t + 0.127414796f; q = q * t;
    const f32x2 s = (v * v) * (-0.72134752044f);
    f32x2 e; e.x = __builtin_amdgcn_exp2f(s.x); e.y = __builtin_amdgcn_exp2f(s.y);
    const f32x2 m = v * (q * e), r = v - m;
    f32x2 o; o.x = v.x < 0.f ? m.x : r.x; o.y = v.y < 0.f ? m.y : r.y; return o;
}

namespace pg8 {
constexpr int BM = 256, BK = 64, HALF = 128, HTB = HALF * BK * 2, STAGE_BYTES = 8 * HTB, NXCD = 8, WGM = 8;
__device__ __forceinline__ int lds_byte(int r, int c) { const int st = (r >> 4) * 2 + (c >> 5), rr = r & 15, cc = c & 31, ob = rr * 64 + cc * 2; return st * 1024 + (ob ^ (((ob >> 9) & 1) << 5)); }
__device__ __forceinline__ void stage_rc(int b, int& R, int& C) { const int st = b / 1024, sb = b % 1024, swz = sb ^ (((sb >> 9) & 1) << 5); R = (st >> 1) * 16 + swz / 64; C = (st & 1) * 32 + (swz % 64) / 2; }
__device__ __forceinline__ int perm32(int rho) { const int n = rho >> 4, i = rho & 15; return 8 * (i >> 2) + 4 * n + (i & 3); }

struct Unit { int pm, pn, bt; };

__device__ __forceinline__ void remap(int L, int nM, int nN, int& pm, int& pn) {
    const int nwg = nM * nN; int wgid = L;
    { const int q = nwg / NXCD, r = nwg % NXCD, xcd = wgid % NXCD, off = wgid / NXCD; wgid = (xcd < r ? xcd * (q + 1) : r * (q + 1) + (xcd - r) * q) + off; }
    const int nig = WGM * nN, gid = wgid / nig, fm = gid * WGM, gsz = (nM - fm) < WGM ? (nM - fm) : WGM;
    pm = fm + ((wgid % nig) % gsz); pn = (wgid % nig) / gsz;
}
struct OrderStd {
    const char* A; const char* Bt; int nM, nN, G, c; size_t tA, tB;
    __device__ __forceinline__ void init(const void* A_, int lda, const void* Bt_, int ldb, int M, int N) { A = (const char*)A_; Bt = (const char*)Bt_; nM = M / BM; nN = N / BM; G = lgdim(); c = lbid(); tA = (size_t)BM * lda * 2; tB = (size_t)BM * ldb * 2; }
    __device__ __forceinline__ bool next(int i, Unit& u) const { const long L = (long)i * G + c; if (L >= (long)nM * nN) return false; remap((int)L, nM, nN, u.pm, u.pn); u.bt = 0; return true; }
    __device__ __forceinline__ const char* a_ptr(const Unit& u) const { return A + (size_t)u.pm * tA; }
    __device__ __forceinline__ const char* b_ptr(const Unit& u) const { return Bt + (size_t)u.pn * tB; }
};
struct OrderMerge {
    const char* A; const char* Bt; int nM, G, c; size_t tA, tB;
    __device__ __forceinline__ void init(const void* A_, int lda, const void* Bt_, int ldb, int M) { A = (const char*)A_; Bt = (const char*)Bt_; nM = M / BM; G = lgdim(); c = lbid(); tA = (size_t)BM * lda * 2; tB = (size_t)BM * ldb * 2; }
    __device__ __forceinline__ bool next(int i, Unit& u) const { const int sup = i / 3, seg = i - sup * 3; const long L = (long)sup * G + c; if (L >= (long)nM * 4) return false; int j; remap((int)L, nM, 4, u.pm, j); u.pn = seg * 4 + j; u.bt = 0; return true; }
    __device__ __forceinline__ const char* a_ptr(const Unit& u) const { return A + (size_t)u.pm * tA; }
    __device__ __forceinline__ const char* b_ptr(const Unit& u) const { return Bt + (size_t)u.pn * tB; }
};
struct OrderBatch {
    const char* A; const char* Bt; int nM, nN, G, c; size_t tA, tB, gA, gB;
    __device__ __forceinline__ void init(const void* A_, int lda, size_t gA_, const void* Bt_, int ldb, size_t gB_, int nM_, int nN_) { A = (const char*)A_; Bt = (const char*)Bt_; nM = nM_; nN = nN_; G = lgdim(); c = lbid(); tA = (size_t)BM * lda * 2; tB = (size_t)BM * ldb * 2; gA = gA_; gB = gB_; }
    __device__ __forceinline__ bool next(int i, Unit& u) const {
        const long L = (long)i * G + c; const int per = nM * nN; if (L >= 16L * per) return false;
        const int x = (int)(L & 7), r = (int)(L >> 3), npx = 2 * per;
        const int g = 2 * x + r / per, t = r % per; (void)npx;
        u.bt = g; u.pm = t / nN; u.pn = t % nN; return true; }
    __device__ __forceinline__ const char* a_ptr(const Unit& u) const { return A + (size_t)u.bt * gA + (size_t)u.pm * tA; }
    __device__ __forceinline__ const char* b_ptr(const Unit& u) const { return Bt + (size_t)u.bt * gB + (size_t)u.pn * tB; }
};

template <bool ALIGN_EPI = true, bool SP2 = true, class Epi, class Sched>
__device__ __forceinline__ void gemm_phase(LAS unsigned char* lds, const Sched& S, const Epi& E, const int K, const int lda, const int ldb, const int wv) {
    int tid_ = ltid(wv);
    const int tid = tid_, wid = __builtin_amdgcn_readfirstlane(tid >> 6), lane = tid & 63, wr = wid >> 2, wc = wid & 3, fr = lane & 15, fq = lane >> 4;
    const int nt = K / BK;
    unsigned voffA[2], voffB[2];
#pragma unroll
    for (int i = 0; i < 2; ++i) { int R, C; stage_rc(tid * 16 + i * 8192, R, C); const int Rb = Epi::PERM ? ((R & ~31) + perm32(R & 31)) : R;
        voffA[i] = (unsigned)(R * lda + C) * 2u; voffB[i] = (unsigned)(Rb * ldb + C) * 2u; }
    const size_t kstep = (size_t)(BK * 2);
    const size_t hstepA = (size_t)HALF * lda * 2, hstepB = (size_t)HALF * ldb * 2;
    const unsigned ldsw = (unsigned)wid * 1024u;
    const int aoff = lds_byte(wr * 64 + fr, fq * 8), boff = lds_byte(wc * 32 + fr, fq * 8);
#define PG8_SA(b, h) (((b) * 2 + (h)) * HTB)
#define PG8_SB(b, h) ((4 + (b) * 2 + (h)) * HTB)
#define PG8_STAGE(bufoff, gbase, voff) do { _Pragma("unroll") for (int _i = 0; _i < 2; ++_i) \
        __builtin_amdgcn_global_load_lds((const unsigned*)((const char*)(gbase) + (voff)[_i]), (LAS unsigned*)(lds + (bufoff) + ldsw + _i * 8192), 16, 0, 0); } while (0)
#define PG8_LDA(dst, b, h) do { _Pragma("unroll") for (int m = 0; m < 4; ++m) _Pragma("unroll") for (int k = 0; k < 2; ++k) dst[m][k] = *(const LAS bf16x8*)(lds + PG8_SA(b, h) + aoff + m * 2048 + k * 1024); } while (0)
#define PG8_LDB(dst, b, h) do { _Pragma("unroll") for (int n = 0; n < 2; ++n) _Pragma("unroll") for (int k = 0; k < 2; ++k) dst[n][k] = *(const LAS bf16x8*)(lds + PG8_SB(b, h) + boff + n * 2048 + k * 1024); } while (0)
#define PG8_MMA(ai, bj, At, Bt) do { __builtin_amdgcn_s_setprio(1); _Pragma("unroll") for (int m = 0; m < 4; ++m) _Pragma("unroll") for (int n = 0; n < 2; ++n) _Pragma("unroll") for (int k = 0; k < 2; ++k) \
        acc[ai][bj][m][n] = __builtin_amdgcn_mfma_f32_16x16x32_bf16(Bt[n][k], At[m][k], acc[ai][bj][m][n], 0, 0, 0); __builtin_amdgcn_s_setprio(0); } while (0)
#define PG8_WAIT_V(n) asm volatile("s_waitcnt vmcnt(" #n ")" ::: "memory")
#define PG8_WAIT_L(n) asm volatile("s_waitcnt lgkmcnt(" #n ")" ::: "memory")
#define PG8_BAR __builtin_amdgcn_s_barrier()
#define PG8_SCHED __builtin_amdgcn_sched_barrier(0)
    Unit cur, nxt; int ui = 0;
    if (!S.next(0, cur)) return;
    f32x4 acc[2][2][4][2];
#pragma unroll
    for (int a = 0; a < 2; ++a)
#pragma unroll
        for (int b = 0; b < 2; ++b)
#pragma unroll
            for (int m = 0; m < 4; ++m)
#pragma unroll
                for (int n = 0; n < 2; ++n) acc[a][b][m][n] = (f32x4){0.f, 0.f, 0.f, 0.f};
    bf16x8 At[4][2], B0[2][2], B1[2][2];
    const char* cA = S.a_ptr(cur); const char* cB = S.b_ptr(cur);
    if constexpr (SP2) {
        PG8_STAGE(PG8_SB(0, 0), cB, voffB); PG8_STAGE(PG8_SB(0, 1), cB + hstepB, voffB); PG8_STAGE(PG8_SA(0, 0), cA, voffA); PG8_STAGE(PG8_SA(0, 1), cA + hstepA, voffA);
        if (wr == 1) PG8_BAR;
        PG8_WAIT_V(2); PG8_BAR;
        PG8_STAGE(PG8_SB(1, 0), cB + kstep, voffB); PG8_STAGE(PG8_SA(1, 0), cA + kstep, voffA); PG8_STAGE(PG8_SB(1, 1), cB + hstepB + kstep, voffB);
        PG8_WAIT_V(6); PG8_BAR;
    } else {
    PG8_STAGE(PG8_SB(0, 0), cB, voffB); PG8_STAGE(PG8_SA(0, 0), cA, voffA); PG8_STAGE(PG8_SB(0, 1), cB + hstepB, voffB); PG8_STAGE(PG8_SA(0, 1), cA + hstepA, voffA);
    if (wr == 1) PG8_BAR;
    PG8_WAIT_V(4); PG8_BAR;
    PG8_STAGE(PG8_SB(1, 0), cB + kstep, voffB); PG8_STAGE(PG8_SA(1, 0), cA + kstep, voffA); PG8_STAGE(PG8_SB(1, 1), cB + hstepB + kstep, voffB);
    PG8_WAIT_V(6); PG8_BAR;
    }
    for (;;) {
        const bool has_next = S.next(ui + 1, nxt);
        float rsv[8];
        if constexpr (Epi::NEEDS_RS) { const int l3 = ltid(wv) & 15; const float* rp = E.rs + cur.pm * BM + wr * 64 + l3;
#pragma unroll
            for (int q8 = 0; q8 < 8; ++q8) rsv[q8] = rp[(q8 >> 2) * HALF + (q8 & 3) * 16]; }
        const char* nA = has_next ? S.a_ptr(nxt) : cA; const char* nB = has_next ? S.b_ptr(nxt) : cB;
        for (int t = 0; t < nt; t += 2) {
            const bool last = (t == nt - 2);
            const char* a1 = cA + (size_t)(t + 1) * kstep;
            const char* a2 = last ? nA : cA + (size_t)(t + 2) * kstep; const char* b2 = last ? nB : cB + (size_t)(t + 2) * kstep;
            const char* a3 = a2 + kstep; const char* b3 = b2 + kstep;
            if constexpr (SP2) {
            PG8_LDB(B0, 0, 0); PG8_LDB(B1, 0, 1); PG8_SCHED; PG8_LDA(At, 0, 0); PG8_STAGE(PG8_SA(1, 1), a1 + hstepA, voffA);
            PG8_WAIT_V(8); PG8_WAIT_L(0); PG8_BAR; PG8_MMA(0, 0, At, B0); PG8_MMA(0, 1, At, B1); PG8_BAR; PG8_SCHED;
            PG8_LDA(At, 0, 1); PG8_STAGE(PG8_SB(0, 0), b2, voffB); PG8_STAGE(PG8_SB(0, 1), b2 + hstepB, voffB); PG8_STAGE(PG8_SA(0, 0), a2, voffA);
            PG8_WAIT_V(8); PG8_WAIT_L(0); PG8_BAR; PG8_MMA(1, 0, At, B0); PG8_MMA(1, 1, At, B1); PG8_BAR; PG8_SCHED;
            PG8_LDB(B0, 1, 0); PG8_LDB(B1, 1, 1); PG8_SCHED; PG8_LDA(At, 1, 0); PG8_STAGE(PG8_SA(0, 1), a2 + hstepA, voffA);
            PG8_WAIT_V(8); PG8_WAIT_L(0); PG8_BAR; PG8_MMA(0, 0, At, B0); PG8_MMA(0, 1, At, B1); PG8_BAR; PG8_SCHED;
            PG8_LDA(At, 1, 1); PG8_STAGE(PG8_SB(1, 0), b3, voffB); PG8_STAGE(PG8_SB(1, 1), b3 + hstepB, voffB); PG8_STAGE(PG8_SA(1, 0), a3, voffA);
            PG8_WAIT_V(8); PG8_WAIT_L(0); PG8_BAR; PG8_MMA(1, 0, At, B0); PG8_MMA(1, 1, At, B1); PG8_BAR; PG8_SCHED;
            } else {
            PG8_LDB(B0, 0, 0); PG8_SCHED; PG8_LDA(At, 0, 0); PG8_STAGE(PG8_SA(1, 1), a1 + hstepA, voffA);
            PG8_WAIT_L(8); PG8_BAR; PG8_WAIT_L(0); PG8_MMA(0, 0, At, B0); PG8_BAR; PG8_SCHED;
            PG8_LDB(B1, 0, 1); PG8_STAGE(PG8_SB(0, 0), b2, voffB);
            PG8_BAR; PG8_WAIT_L(0); PG8_MMA(0, 1, At, B1); PG8_BAR;
            PG8_LDA(At, 0, 1); PG8_STAGE(PG8_SA(0, 0), a2, voffA);
            PG8_BAR; PG8_WAIT_L(0); PG8_MMA(1, 0, At, B0); PG8_BAR; PG8_SCHED;
            PG8_STAGE(PG8_SB(0, 1), b2 + hstepB, voffB);
            PG8_WAIT_V(6); PG8_BAR; PG8_MMA(1, 1, At, B1); PG8_BAR;
            PG8_LDB(B0, 1, 0); PG8_SCHED; PG8_LDA(At, 1, 0); PG8_STAGE(PG8_SA(0, 1), a2 + hstepA, voffA);
            PG8_WAIT_L(8); PG8_BAR; PG8_WAIT_L(0); PG8_MMA(0, 0, At, B0); PG8_BAR; PG8_SCHED;
            PG8_LDB(B1, 1, 1); PG8_STAGE(PG8_SB(1, 0), b3, voffB);
            PG8_BAR; PG8_WAIT_L(0); PG8_MMA(0, 1, At, B1); PG8_BAR;
            PG8_LDA(At, 1, 1); PG8_STAGE(PG8_SA(1, 0), a3, voffA);
            PG8_BAR; PG8_WAIT_L(0); PG8_MMA(1, 0, At, B0); PG8_BAR; PG8_SCHED;
            PG8_STAGE(PG8_SB(1, 1), b3 + hstepB, voffB);
            PG8_WAIT_V(6); PG8_BAR; PG8_MMA(1, 1, At, B1); PG8_BAR;
            }
        }
        if constexpr (ALIGN_EPI) { if (wr == 0) PG8_BAR; }
        { const int l2 = ltid(wv) & 63; E(acc, cur, wr, wc, l2 & 15, l2 >> 4, rsv); }
        if (!has_next) break;
#pragma unroll
        for (int a = 0; a < 2; ++a)
#pragma unroll
            for (int b = 0; b < 2; ++b)
#pragma unroll
                for (int m = 0; m < 4; ++m)
#pragma unroll
                    for (int n = 0; n < 2; ++n) acc[a][b][m][n] = (f32x4){0.f, 0.f, 0.f, 0.f};
        cur = nxt; cA = nA; cB = nB; ++ui;
        if constexpr (ALIGN_EPI) { if (wr == 1) PG8_BAR; }
    }
    PG8_WAIT_V(0);
    if constexpr (!ALIGN_EPI) { if (wr == 0) PG8_BAR; }
    PG8_BAR;
#undef PG8_SA
#undef PG8_SB
#undef PG8_STAGE
#undef PG8_LDA
#undef PG8_LDB
#undef PG8_MMA
#undef PG8_WAIT_V
#undef PG8_WAIT_L
#undef PG8_BAR
#undef PG8_SCHED
}

typedef const f32x4 (&AccRef)[2][2][4][2];

struct EpiZ {
    static constexpr bool PERM = true; static constexpr bool NEEDS_RS = true; bf16_t* z; bf16_t* uc; const float* rs;
    __device__ __forceinline__ void operator()(AccRef acc, const Unit& u, int wr, int wc, int fr, int fq, const float (&rsv)[8]) const {
        const int row0 = u.pm * BM + wr * 64 + fr;
#pragma unroll
        for (int ai = 0; ai < 2; ++ai)
#pragma unroll
            for (int m = 0; m < 4; ++m) { const int r = row0 + ai * HALF + m * 16;
#pragma unroll
                for (int bj = 0; bj < 2; ++bj) { const f32x4 v0 = acc[ai][bj][m][0] * rsv[ai * 4 + m], v1 = acc[ai][bj][m][1] * rsv[ai * 4 + m];
                    u32x4 w; w.x = pk2(v0[0], v0[1]); w.y = pk2(v0[2], v0[3]); w.z = pk2(v1[0], v1[1]); w.w = pk2(v1[2], v1[3]);
                    const int c0 = u.pn * BM + bj * HALF + wc * 32 + 8 * fq;
                    if (u.pn == 4) { const int cc = c0 - C_SU, g = cc >> 4, c8 = cc & 15, b = r >> 12, t = r & 4095;
                        *(u32x4*)(uc + ((size_t)(g * 1024 + b * 64 + (t >> 6)) * 1280 + (t & 63) * 16 + c8)) = w; }
                    else { const int tb = r >> 6, i = r & 63; size_t off;
                        if (c0 < 1024) off = ZR_OFF + ((size_t)(tb * 4 + ((c0 >> 6) & 3)) * 64 + i) * 256 + (c0 >> 8) * 64 + (c0 & 63);
                        else if (c0 < C_GV) off = ZG_OFF + ((size_t)(tb * 4 + (((c0 - C_GQ) >> 6) & 3)) * 64 + i) * 384 + ((c0 - C_GQ) >> 8) * 64 + (c0 & 63);
                        else if (c0 < C_LR) { const int cc = c0 - C_GV, sec = cc >> 9, hh = (cc >> 7) & 3; off = ZG_OFF + ((size_t)(tb * 4 + hh) * 64 + i) * 384 + 128 + sec * 128 + (cc & 127); }
                        else off = ZL_OFF + (size_t)r * 16 + (c0 - C_LR);
                        if (c0 < C_LR + 16) *(u32x4*)(z + off) = w; } } }
    }
};
struct EpiXloc {
    static constexpr bool PERM = false; static constexpr bool NEEDS_RS = false; float* X;
    __device__ __forceinline__ void operator()(AccRef acc, const Unit& u, int wr, int wc, int fr, int fq, const float (&rsv)[8]) const {
        float* base = X + (size_t)u.bt * 1024 * 256; const int row0 = u.pm * BM + wr * 64 + fr, col0 = wc * 32 + 4 * fq;
#pragma unroll
        for (int ai = 0; ai < 2; ++ai)
#pragma unroll
            for (int m = 0; m < 4; ++m) { float* rowp = base + (size_t)(row0 + ai * HALF + m * 16) * 256 + col0;
#pragma unroll
                for (int bj = 0; bj < 2; ++bj)
#pragma unroll
                    for (int n = 0; n < 2; ++n) *(f32x4*)(rowp + bj * HALF + n * 16) = acc[ai][bj][m][n]; }
    }
};
struct EpiS5Y {
    static constexpr bool PERM = true; static constexpr bool NEEDS_RS = false; bf16_t* Y;
    __device__ __forceinline__ void operator()(AccRef acc, const Unit& u, int wr, int wc, int fr, int fq, const float (&rsv)[8]) const {
        const int row0 = u.pm * BM + wr * 64 + fr;
#pragma unroll
        for (int ai = 0; ai < 2; ++ai)
#pragma unroll
            for (int m = 0; m < 4; ++m) { const int r = row0 + ai * HALF + m * 16;
                const int b = r >> 6, n = r & 63;
#pragma unroll
                for (int bj = 0; bj < 2; ++bj) { const f32x4 v0 = acc[ai][bj][m][0], v1 = acc[ai][bj][m][1];
                    const f32x2 a = gelu_pk((f32x2){v0[0], v0[1]}), bb = gelu_pk((f32x2){v0[2], v0[3]}), c = gelu_pk((f32x2){v1[0], v1[1]}), d = gelu_pk((f32x2){v1[2], v1[3]});
                    u32x4 w; w.x = pk2(a.x, a.y); w.y = pk2(bb.x, bb.y); w.z = pk2(c.x, c.y); w.w = pk2(d.x, d.y);
                    const int c0 = u.pn * BM + bj * HALF + wc * 32 + 8 * fq, t = c0 >> 4, c8 = c0 & 15;
                    *(u32x4*)(Y + (size_t)(b * SEQ + n * 64 + t) * 256 + u.bt * 16 + c8) = w; } }
    }
};
template <int ACT  > struct EpiBf16 {
    static constexpr bool PERM = true; static constexpr bool NEEDS_RS = (ACT == 1); bf16_t* O; int ldc; const float* rs;
    __device__ __forceinline__ void operator()(AccRef acc, const Unit& u, int wr, int wc, int fr, int fq, const float (&rsv)[8]) const {
        const int row0 = u.pm * BM + wr * 64 + fr, col0 = u.pn * BM + wc * 32 + 8 * fq;
#pragma unroll
        for (int ai = 0; ai < 2; ++ai)
#pragma unroll
            for (int m = 0; m < 4; ++m) { bf16_t* rowp = O + (size_t)(row0 + ai * HALF + m * 16) * ldc + col0;
#pragma unroll
                for (int bj = 0; bj < 2; ++bj) { f32x4 v0 = acc[ai][bj][m][0], v1 = acc[ai][bj][m][1];
                    if (ACT == 1) { v0 = v0 * rsv[ai * 4 + m]; v1 = v1 * rsv[ai * 4 + m]; }
                    if (ACT == 1) {
#pragma unroll
                        for (int j = 0; j < 4; ++j) { const float a = __builtin_amdgcn_fmed3f(v0[j], 0.f, 3.0e38f), b = __builtin_amdgcn_fmed3f(v1[j], 0.f, 3.0e38f); v0[j] = a * a; v1[j] = b * b; } }
                    u32x4 w; w.x = pk2(v0[0], v0[1]); w.y = pk2(v0[2], v0[3]); w.z = pk2(v1[0], v1[1]); w.w = pk2(v1[2], v1[3]);
                    *(u32x4*)(rowp + bj * HALF) = w; } }
    }
};
struct EpiGLU {
    static constexpr bool PERM = true; static constexpr bool NEEDS_RS = false; bf16_t* O;
    __device__ __forceinline__ void operator()(AccRef acc, const Unit& u, int wr, int wc, int fr, int fq, const float (&rsv)[8]) const {
        const int row0 = u.pm * BM + wr * 64 + fr, col0 = u.pn * HALF + wc * 32 + 8 * fq;
#pragma unroll
        for (int ai = 0; ai < 2; ++ai)
#pragma unroll
            for (int m = 0; m < 4; ++m) { bf16_t* rowp = O + (size_t)(row0 + ai * HALF + m * 16) * DM + col0;
                f32x4 v0 = acc[ai][0][m][0], v1 = acc[ai][0][m][1]; const f32x4 g0 = acc[ai][1][m][0], g1 = acc[ai][1][m][1];
#pragma unroll
                for (int j = 0; j < 4; ++j) { v0[j] *= sigmoidf_(g0[j]); v1[j] *= sigmoidf_(g1[j]); }
                u32x4 w; w.x = pk2(v0[0], v0[1]); w.y = pk2(v0[2], v0[3]); w.z = pk2(v1[0], v1[1]); w.w = pk2(v1[2], v1[3]);
                *(u32x4*)rowp = w; }
    }
};
struct EpiMerge {
    static constexpr bool PERM = true; static constexpr bool NEEDS_RS = true; const bf16_t* br; bf16_t* mg; const float* bias; const float* rs;
    __device__ __forceinline__ void operator()(AccRef acc, const Unit& u, int wr, int wc, int fr, int fq, const float (&rsv)[8]) const {
        const int seg = u.pn >> 2, j = u.pn & 3;
        const int row0 = u.pm * BM + wr * 64 + fr, ch0 = j * BM + wc * 32 + 8 * fq;
        const bf16_t* brs = br + (size_t)seg * NTOK * DM;
        f32x4 bv[2][2];
#pragma unroll
        for (int bj = 0; bj < 2; ++bj)
#pragma unroll
            for (int n = 0; n < 2; ++n) bv[bj][n] = *(const f32x4*)(bias + seg * DM + ch0 + bj * HALF + 4 * n);
#pragma unroll
        for (int ai = 0; ai < 2; ++ai)
#pragma unroll
            for (int m = 0; m < 4; ++m) { const size_t ro = (size_t)(row0 + ai * HALF + m * 16) * DM + ch0;
#pragma unroll
                for (int bj = 0; bj < 2; ++bj) { const f32x4 a0 = acc[ai][bj][m][0] * rsv[ai * 4 + m] + bv[bj][0], a1 = acc[ai][bj][m][1] * rsv[ai * 4 + m] + bv[bj][1];
                    const u32x4 bw = *(const u32x4*)(brs + ro + bj * HALF);
                    float r[8];
                    r[0] = bf2f(bw.x & 0xffffu) * sigmoidf_(a0[0]); r[1] = bf2f(bw.x >> 16) * sigmoidf_(a0[1]); r[2] = bf2f(bw.y & 0xffffu) * sigmoidf_(a0[2]); r[3] = bf2f(bw.y >> 16) * sigmoidf_(a0[3]);
                    r[4] = bf2f(bw.z & 0xffffu) * sigmoidf_(a1[0]); r[5] = bf2f(bw.z >> 16) * sigmoidf_(a1[1]); r[6] = bf2f(bw.w & 0xffffu) * sigmoidf_(a1[2]); r[7] = bf2f(bw.w >> 16) * sigmoidf_(a1[3]);
                    if (seg != 0) { const u32x4 mw = *(const u32x4*)(mg + ro + bj * HALF);
                        r[0] += bf2f(mw.x & 0xffffu); r[1] += bf2f(mw.x >> 16); r[2] += bf2f(mw.y & 0xffffu); r[3] += bf2f(mw.y >> 16);
                        r[4] += bf2f(mw.z & 0xffffu); r[5] += bf2f(mw.z >> 16); r[6] += bf2f(mw.w & 0xffffu); r[7] += bf2f(mw.w >> 16); }
                    u32x4 w; w.x = pk2(r[0], r[1]); w.y = pk2(r[2], r[3]); w.z = pk2(r[4], r[5]); w.w = pk2(r[6], r[7]);
                    *(u32x4*)(mg + ro + bj * HALF) = w; } }
    }
};
struct EpiResNorm {
    static constexpr bool PERM = true; static constexpr bool NEEDS_RS = false; static constexpr int PMODE = 1; const float* Xin; float* X; bf16_t* XG; const float* g; float* slots;
    __device__ __forceinline__ void operator()(AccRef acc, const Unit& u, int wr, int wc, int fr, int fq, const float (&rsv)[8]) const {
        const int row0 = u.pm * BM + wr * 64 + fr, col0 = u.pn * BM + wc * 32 + 8 * fq, lane = fq * 16 + fr;
        f32x4 gv[2][2];
#pragma unroll
        for (int bj = 0; bj < 2; ++bj)
#pragma unroll
            for (int n = 0; n < 2; ++n) gv[bj][n] = XG ? *(const f32x4*)(g + col0 + bj * HALF + n * 4) : (f32x4){0.f, 0.f, 0.f, 0.f};
#pragma unroll
        for (int ai = 0; ai < 2; ++ai)
#pragma unroll
            for (int m = 0; m < 4; ++m) { const int r = row0 + ai * HALF + m * 16; const size_t ro = (size_t)r * DM + col0; float ss = 0.f;
#pragma unroll
                for (int bj = 0; bj < 2; ++bj) { const f32x4* qi = (const f32x4*)(Xin + ro + bj * HALF); f32x4* qo = (f32x4*)(X + ro + bj * HALF);
                    const f32x4 v0 = qi[0] + acc[ai][bj][m][0], v1 = qi[1] + acc[ai][bj][m][1]; qo[0] = v0; qo[1] = v1;
                    ss += (v0[0] * v0[0] + v0[1] * v0[1]) + (v0[2] * v0[2] + v0[3] * v0[3]) + (v1[0] * v1[0] + v1[1] * v1[1]) + (v1[2] * v1[2] + v1[3] * v1[3]);
                    if (XG) { const f32x4 y0 = v0 * gv[bj][0], y1 = v1 * gv[bj][1]; u32x4 w; w.x = pk2(y0[0], y0[1]); w.y = pk2(y0[2], y0[3]); w.z = pk2(y1[0], y1[1]); w.w = pk2(y1[2], y1[3]);
                        *(u32x4*)(XG + ro + bj * HALF) = w; } }
                ss += shx(ss, 16, lane); ss += shx(ss, 32, lane);
                if (fq == 0) slots[(size_t)r * 16 + u.pn * 4 + wc] = ss; }
    }
};
}

__device__ __forceinline__ float wave_sum(float v, int lane) {
#pragma unroll
    for (int o = 1; o < 64; o <<= 1) v += shx(v, o, lane);
    return v;
}
__device__ __forceinline__ void rmsnorm_phase(const float* xin, float* xcopy, const float* g, bf16_t* h, const int wv) {
    const int tid = ltid(wv), lane = tid & 63, wave = tid >> 6, step = lgdim() * 8;
    f32x4 gv[4];
#pragma unroll
    for (int i = 0; i < 4; ++i) gv[i] = *(const f32x4*)(g + i * 256 + lane * 4);
    int row = lbid() * 8 + wave; f32x4 v[4], nv[4];
    if (row < NTOK) {
#pragma unroll
        for (int i = 0; i < 4; ++i) v[i] = *(const f32x4*)(xin + (size_t)row * DM + i * 256 + lane * 4); }
    for (; row < NTOK; row += step) {
        if (row + step < NTOK) {
#pragma unroll
            for (int i = 0; i < 4; ++i) nv[i] = *(const f32x4*)(xin + (size_t)(row + step) * DM + i * 256 + lane * 4); }
        float s = 0.f;
#pragma unroll
        for (int i = 0; i < 4; ++i) s += v[i][0] * v[i][0] + v[i][1] * v[i][1] + v[i][2] * v[i][2] + v[i][3] * v[i][3];
        s = wave_sum(s, lane); const float rs = __builtin_amdgcn_rsqf(s * (1.0f / DM) + EPS);
#pragma unroll
        for (int i = 0; i < 4; ++i) { u32x2 w; w.x = pk2(v[i][0] * rs * gv[i][0], v[i][1] * rs * gv[i][1]); w.y = pk2(v[i][2] * rs * gv[i][2], v[i][3] * rs * gv[i][3]);
            *(u32x2*)(h + (size_t)row * DM + i * 256 + lane * 4) = w;
            if (xcopy) *(f32x4*)(xcopy + (size_t)row * DM + i * 256 + lane * 4) = v[i]; }
#pragma unroll
        for (int i = 0; i < 4; ++i) v[i] = nv[i];
    }
}
__device__ __forceinline__ float slot_rs(const float* slots, int r) { const f32x4* p = (const f32x4*)(slots + (size_t)r * 16); const f32x4 a = p[0], b = p[1], c = p[2], d = p[3];
    const float s = ((a[0] + a[1]) + (a[2] + a[3])) + ((b[0] + b[1]) + (b[2] + b[3])) + ((c[0] + c[1]) + (c[2] + c[3])) + ((d[0] + d[1]) + (d[2] + d[3]));
    return __builtin_amdgcn_rsqf(s * (1.0f / DM) + EPS); }
__device__ __forceinline__ void rs_phase(const float* slots, float* rs, const int wv) { for (int r = lbid() * 512 + ltid(wv); r < NTOK; r += lgdim() * 512) rs[r] = slot_rs(slots, r); }
__device__ __forceinline__ void prep0_phase(const float* xin, const float* g, bf16_t* xg, float* rs, const int wv) {
    const int tid = ltid(wv), lane = tid & 63, wave = tid >> 6;
    f32x4 gv[4];
#pragma unroll
    for (int i = 0; i < 4; ++i) gv[i] = *(const f32x4*)(g + i * 256 + lane * 4);
    for (int row = lbid() * 8 + wave; row < NTOK; row += lgdim() * 8) {
        const float* xr = xin + (size_t)row * DM; f32x4 v[4]; float s = 0.f;
#pragma unroll
        for (int i = 0; i < 4; ++i) { v[i] = *(const f32x4*)(xr + i * 256 + lane * 4); s += v[i][0] * v[i][0] + v[i][1] * v[i][1] + v[i][2] * v[i][2] + v[i][3] * v[i][3]; }
        s = wave_sum(s, lane);
        if (lane == 0) rs[row] = __builtin_amdgcn_rsqf(s * (1.0f / DM) + EPS);
#pragma unroll
        for (int i = 0; i < 4; ++i) { u32x2 w; w.x = pk2(v[i][0] * gv[i][0], v[i][1] * gv[i][1]); w.y = pk2(v[i][2] * gv[i][2], v[i][3] * gv[i][3]);
            *(u32x2*)(xg + (size_t)row * DM + i * 256 + lane * 4) = w; }
    }
}
__device__ __forceinline__ void final_norm_phase(float* x, const float* g, const float* slots, const int wv) {
    const int tid = ltid(wv), lane = tid & 63, wave = tid >> 6;
    f32x4 gv[4];
#pragma unroll
    for (int i = 0; i < 4; ++i) gv[i] = *(const f32x4*)(g + i * 256 + lane * 4);
    for (int row = lbid() * 8 + wave; row < NTOK; row += lgdim() * 8) {
        float* xr = x + (size_t)row * DM; const float rs = slot_rs(slots, row);
#pragma unroll
        for (int i = 0; i < 4; ++i) { const f32x4 v = *(const f32x4*)(xr + i * 256 + lane * 4); *(f32x4*)(xr + i * 256 + lane * 4) = v * rs * gv[i]; }
    }
}

template <class Map>
__device__ __forceinline__ void conv_issue(const float* src, int Nsrc, int ntn, int t, int tid, Map map, float (&r)[8]) {
    const int tn = t % ntn, tk = t / ntn;
#pragma unroll
    for (int it = 0; it < 8; ++it) { const int idx = it * 512 + tid, kk = idx >> 6, nn = idx & 63; const int col = map(tn * 64 + nn);
        r[it] = col >= 0 ? src[(size_t)(tk * 64 + kk) * Nsrc + col] : 0.f; }
}
template <class Map>
__device__ __forceinline__ void conv_T(LAS unsigned char* lds, const float* src, int K, int Nsrc, bf16_t* dst, int Ndst, Map map, const int wv) {
    LAS float* tile = (LAS float*)lds;
    const int tid = ltid(wv), ntn = Ndst / 64, ntiles = ntn * (K / 64), G = lgdim();
    float cur[8], nx1[8], nx2[8];
    int t = lbid();
    if (t < ntiles) conv_issue(src, Nsrc, ntn, t, tid, map, cur);
    if (t + G < ntiles) conv_issue(src, Nsrc, ntn, t + G, tid, map, nx1);
    for (; t < ntiles; t += G) {
        if (t + 2 * G < ntiles) conv_issue(src, Nsrc, ntn, t + 2 * G, tid, map, nx2);
        const int tn = t % ntn, tk = t / ntn;
#pragma unroll
        for (int it = 0; it < 8; ++it) { const int idx = it * 512 + tid, kk = idx >> 6, nn = idx & 63; tile[nn * 65 + kk] = cur[it]; }
        asm volatile("s_waitcnt lgkmcnt(0)\n\ts_barrier" ::: "memory");
        { const int nn = tid >> 3, sg = tid & 7; LAS const float* tp = tile + nn * 65 + sg * 8;
          u32x4 w; w.x = pk2(tp[0], tp[1]); w.y = pk2(tp[2], tp[3]); w.z = pk2(tp[4], tp[5]); w.w = pk2(tp[6], tp[7]);
          *(u32x4*)(dst + (size_t)(tn * 64 + nn) * K + tk * 64 + sg * 8) = w; }
        asm volatile("s_waitcnt lgkmcnt(0)\n\ts_barrier" ::: "memory");
#pragma unroll
        for (int it = 0; it < 8; ++it) { cur[it] = nx1[it]; nx1[it] = nx2[it]; }
    }
}
struct MapId { __device__ __forceinline__ int operator()(int n) const { return n; } };
struct MapZ { __device__ __forceinline__ int operator()(int n) const { return n < 2304 ? n : (n < 2816 ? n + 16 : (n < 2832 ? n - 512 : -1)); } };
struct MapGLU { __device__ __forceinline__ int operator()(int n) const { const int pn = n >> 8, bj = (n >> 7) & 1, i = n & 127; return bj * 1024 + pn * 128 + i; } };

__device__ __forceinline__ void s5_prep(LAS unsigned char* lds, const S5In p, int l, int unit, bf16_t* T1t, bf16_t* T2t, const int wv) {
    const int tid = ltid(wv), g = unit >> 4, c = unit & 15;
    LAS f32x2* Lpow = (LAS f32x2*)lds;
    LAS f32x2* Bb = (LAS f32x2*)(lds + 66560);
    LAS f32x2* Wm = (LAS f32x2*)(lds + 66560 + 16384);
    LAS float* Kt = (LAS float*)(lds + 66560 + 32768);
    const float* lam_re = p.lam_re + (size_t)l * 2048; const float* lam_im = p.lam_im + (size_t)l * 2048; const float* log_dt = p.log_dt + (size_t)l * 32;
    const float* b_re = p.b_re + (size_t)l * 32768; const float* b_im = p.b_im + (size_t)l * 32768;
    const float* c_re = p.c_re + (size_t)l * 32768; const float* c_im = p.c_im + (size_t)l * 32768;
    {
        const int dp = tid >> 2, dir = dp >> 6, pp = dp & 63, q4 = tid & 3;
        const float lr = lam_re[(dir * 16 + g) * 64 + pp], li = lam_im[(dir * 16 + g) * 64 + pp], dt = __expf(log_dt[dir * 16 + g]);
        for (int tau = q4; tau <= 64; tau += 4) { const float mag = __expf(lr * dt * (float)tau); float s, cs; sincos_turns((double)li * (double)dt * (double)tau * INV2PI, s, cs);
            Lpow[(dir * 64 + pp) * 65 + tau] = (f32x2){mag * cs, mag * s}; }
        const float mag1 = __expf(lr * dt); float s1, c1; sincos_turns((double)li * (double)dt * INV2PI, s1, c1);
        const float nr = mag1 * c1 - 1.0f, ni = mag1 * s1, den = 1.0f / (lr * lr + li * li);
        const float rr = (nr * lr + ni * li) * den, ri = (ni * lr - nr * li) * den;
#pragma unroll
        for (int e = 0; e < 4; ++e) { const int cp = q4 * 4 + e; const float br = b_re[((dir * 16 + g) * 64 + pp) * 16 + cp], bi = b_im[((dir * 16 + g) * 64 + pp) * 16 + cp];
            Bb[(dir * 64 + pp) * 16 + cp] = (f32x2){rr * br - ri * bi, rr * bi + ri * br}; }
    }
    __syncthreads();
#pragma unroll
    for (int k = 0; k < 4; ++k) { const int idx = tid + 512 * k, dir = idx >> 10, pp = (idx >> 4) & 63;
        const float cr = c_re[((dir * 16 + g) * 16 + c) * 64 + pp], ci = c_im[((dir * 16 + g) * 16 + c) * 64 + pp]; const f32x2 b = Bb[idx];
        Wm[idx] = (f32x2){cr * b.x - ci * b.y, cr * b.y + ci * b.x}; }
    __syncthreads();
#pragma unroll
    for (int k = 0; k < 4; ++k) { const int idx = tid + 512 * k, dir = idx >> 10, tau = (idx >> 4) & 63, cp = idx & 15; float s = 0.f;
        for (int pp = 0; pp < 64; ++pp) { const f32x2 w = Wm[(dir * 64 + pp) * 16 + cp], L = Lpow[(dir * 64 + pp) * 65 + tau]; s += w.x * L.x - w.y * L.y; }
        Kt[idx] = s; }
    __syncthreads();
    const float Dv = p.d[l * 256 + g * 16 + c];
    for (int k = 0; k < 20; ++k) { const int seg = tid + 512 * k, t = seg / 160, sk = seg - t * 160; float v[8];
        if (sk < 128) { const int s = sk >> 1, c0 = (sk & 1) * 8;
#pragma unroll
            for (int e = 0; e < 8; ++e) { const int cp = c0 + e; float a = 0.f; if (t >= s) a += Kt[(t - s) * 16 + cp]; if (s >= t) a += Kt[1024 + (s - t) * 16 + cp]; if (s == t && cp == c) a += Dv; v[e] = a; } }
        else { const int kk = (sk - 128) * 8, which = kk >> 6, p0 = kk & 63, dir = which >> 1, im = which & 1, tau = dir == 0 ? t + 1 : 64 - t;
#pragma unroll
            for (int e = 0; e < 8; ++e) { const int pp = p0 + e; const float cr = c_re[((dir * 16 + g) * 16 + c) * 64 + pp], ci = c_im[((dir * 16 + g) * 16 + c) * 64 + pp]; const f32x2 L = Lpow[(dir * 64 + pp) * 65 + tau];
                v[e] = im ? -(cr * L.y + ci * L.x) : (cr * L.x - ci * L.y); } }
        u32x4 w; w.x = pk2(v[0], v[1]); w.y = pk2(v[2], v[3]); w.z = pk2(v[4], v[5]); w.w = pk2(v[6], v[7]);
        *(u32x4*)(T2t + ((size_t)g * 1024 + t * 16 + c) * 1280 + sk * 8) = w; }
#pragma unroll
    for (int k = 0; k < 4; ++k) { const int seg = tid + 512 * k, rr = seg >> 7, sk = seg & 127, dir = rr >> 3, ri = (rr >> 2) & 1, pp = 4 * c + (rr & 3), s = sk >> 1, c0 = (sk & 1) * 8;
        const f32x2 L = Lpow[(dir * 64 + pp) * 65 + (dir == 0 ? 63 - s : s)]; float v[8];
#pragma unroll
        for (int e = 0; e < 8; ++e) { const f32x2 b = Bb[(dir * 64 + pp) * 16 + c0 + e]; v[e] = ri ? (L.x * b.y + L.y * b.x) : (L.x * b.x - L.y * b.y); }
        u32x4 w; w.x = pk2(v[0], v[1]); w.y = pk2(v[2], v[3]); w.z = pk2(v[4], v[5]); w.w = pk2(v[6], v[7]);
        *(u32x4*)(T1t + ((size_t)g * 256 + dir * 128 + ri * 64 + pp) * 1024 + sk * 8) = w; }
    __syncthreads();
}
constexpr int L_BF = 0, L_BB = 16640, L_QIN = 33280, L_KIN = 42496, L_P = 51712, L_VT = 60928, L_ST = 79360, L_LR = 97792  , L_WG = 102912  ,
              L_BG = 113152  , L_TOT = 113664, L_NG = 117760  ;
constexpr int GS = 40;
constexpr int RS = 72;
template <int DV, bool GATED> struct Bla {
    const bf16_t* z; const bf16_t* zl; const float* wg; const float* bg; bf16_t* st; float* dec; const float* ng; bf16_t* out; int ldo;
};
__device__ __forceinline__ void lds_barrier() { asm volatile("s_waitcnt lgkmcnt(0)\n\ts_barrier" ::: "memory"); }
__device__ __forceinline__ bf16x8 frag(LAS const bf16_t* base, int row0, int kb, int lane) { return *(LAS const bf16x8*)(base + (row0 + (lane & 15)) * RS + kb * 32 + (lane >> 4) * 8); }
__device__ __forceinline__ void unpack4(u32x2 w, float* o) { o[0] = bf2f(w.x & 0xffffu); o[1] = bf2f(w.x >> 16); o[2] = bf2f(w.y & 0xffffu); o[3] = bf2f(w.y >> 16); }

template <int DV, bool GATED, bool S2> struct BlaRegs { u32x2 k0, k1, q0, q1; u32x4 lrf; u32x4 v[DV / 64]; u32x4 st[2][DV / 64]; u32x4 og[DV / 64]; };
template <int DV, bool GATED, bool S2>
__device__ __forceinline__ void bla_issue(const Bla<DV, GATED>& P, int unit, int tid, BlaRegs<DV, GATED, S2>& R) {
    const int b = unit >> 8, n = (unit >> 2) & 63, h = unit & 3, j = tid >> 3, sg = tid & 7; const int tok0 = b * SEQ + n * 64;
    constexpr int ROW = 128 + 2 * DV;
    const bf16_t* zr = P.z + ((size_t)((b * 64 + n) * 4 + h) * 64 + j) * ROW;
    R.k0 = *(const u32x2*)(zr + 64 + sg * 4); R.k1 = *(const u32x2*)(zr + 64 + 32 + sg * 4);
    if (S2) { R.q0 = *(const u32x2*)(zr + sg * 4); R.q1 = *(const u32x2*)(zr + 32 + sg * 4); }
    constexpr int NV = DV / 8;
#pragma unroll
    for (int q = 0; q < NV / 8; ++q) R.v[q] = *(const u32x4*)(zr + 128 + sg * NV + q * 8);
    if (GATED) { const int lane = tid & 63, jt = (tid >> 6) & 3;
        R.lrf = (lane < 32) ? *(const u32x4*)(P.zl + (size_t)(tok0 + jt * 16 + (lane & 15)) * 16 + (lane >> 4) * 8) : (u32x4){0u, 0u, 0u, 0u}; }
    if (S2) {
#pragma unroll
        for (int dir = 0; dir < 2; ++dir) { const bf16_t* stb = P.st + ((size_t)((b * 4 + h) * 2 + dir) * 64 + n) * (DV * 64);
#pragma unroll
            for (int q = 0; q < DV / 64; ++q) { const int sgi = tid + 512 * q, e = sgi >> 3, d8 = (sgi & 7) * 8; R.st[dir][q] = *(const u32x4*)(stb + e * 64 + d8); } }
#pragma unroll
        for (int q = 0; q < NV / 8; ++q) R.og[q] = *(const u32x4*)(zr + 128 + DV + sg * NV + q * 8);
    }
}
template <int DV, bool GATED>
__device__ __forceinline__ void bla_head_consts(LAS unsigned char* lds, const Bla<DV, GATED>& P, int h, int tid) {
    LAS bf16_t* wgt = (LAS bf16_t*)(lds + L_WG); LAS bf16_t* lra = (LAS bf16_t*)(lds + L_LR); LAS float* bgs = (LAS float*)(lds + L_BG); LAS float* ngs = (LAS float*)(lds + L_NG);
    if (GATED) {
#pragma unroll
        for (int k = 0; k < 4; ++k) { const int idx = tid + 512 * k, dir = idx >> 10, r = (idx >> 6) & 15, d = idx & 63; wgt[(dir * 64 + d) * GS + r] = (bf16_t)f2bf(P.wg[(dir * 16 + r) * 256 + h * 64 + d]); }
#pragma unroll
        for (int k = 0; k < 4; ++k) { const int idx = tid + 512 * k, c = idx >> 4, r = 16 + (idx & 15); wgt[c * GS + r] = 0; }
        for (int idx = tid; idx < 1024; idx += 512) lra[(idx >> 4) * GS + 16 + (idx & 15)] = 0;
        if (tid < 128) bgs[tid] = P.bg[(tid >> 6) * 256 + h * 64 + (tid & 63)];
    }
    if (tid < DV) ngs[tid] = P.ng[h * DV + tid];
    lds_barrier();
}

template <int DV, bool GATED, bool S2>
__device__ __forceinline__ void bla_front(LAS unsigned char* lds, const BlaRegs<DV, GATED, S2>& R, int n, int h, int tid, float (&klo)[4], float (&khi)[4], float (&qlo)[4], float (&qhi)[4]) {
    const int j = tid >> 3, sg = tid & 7;
    LAS float* bf = (LAS float*)(lds + L_BF); LAS float* bb = (LAS float*)(lds + L_BB); LAS bf16_t* vT = (LAS bf16_t*)(lds + L_VT);
    unpack4(R.k0, klo); unpack4(R.k1, khi);
    if (S2) { unpack4(R.q0, qlo); unpack4(R.q1, qhi);
#pragma unroll
        for (int e = 0; e < 4; ++e) { qlo[e] *= 0.125f; qhi[e] *= 0.125f; } }
    if (!GATED) {
        const float pos = (float)(n * 64 + j);
#pragma unroll
        for (int e = 0; e < 4; ++e) { const int i = sg * 4 + e; const float inv = __builtin_amdgcn_exp2f(-(float)i * (13.287712379549449f / 32.0f)); float s, c; sincos_turns((double)pos * (double)inv * INV2PI, s, c);
            const float a = klo[e], bq = khi[e]; klo[e] = a * c - bq * s; khi[e] = a * s + bq * c;
            if (S2) { const float a2 = qlo[e], b2 = qhi[e]; qlo[e] = a2 * c - b2 * s; qhi[e] = a2 * s + b2 * c; } }
    }
    if (S2) {
        constexpr int NV = DV / 8;
#pragma unroll
        for (int q = 0; q < NV / 8; ++q) { const u32x4 w = R.v[q]; const int e0 = sg * NV + q * 8;
            vT[(e0 + 0) * RS + j] = (bf16_t)(w.x & 0xffffu); vT[(e0 + 1) * RS + j] = (bf16_t)(w.x >> 16); vT[(e0 + 2) * RS + j] = (bf16_t)(w.y & 0xffffu); vT[(e0 + 3) * RS + j] = (bf16_t)(w.y >> 16);
            vT[(e0 + 4) * RS + j] = (bf16_t)(w.z & 0xffffu); vT[(e0 + 5) * RS + j] = (bf16_t)(w.z >> 16); vT[(e0 + 6) * RS + j] = (bf16_t)(w.w & 0xffffu); vT[(e0 + 7) * RS + j] = (bf16_t)(w.w >> 16); }
    } else {
        constexpr int NV = DV / 8, RSV = DV + 16;
#pragma unroll
        for (int q = 0; q < NV / 8; ++q) *(LAS u32x4*)(vT + j * RSV + sg * NV + q * 8) = R.v[q];
    }
    if (GATED) {
        LAS bf16_t* lra = (LAS bf16_t*)(lds + L_LR); LAS const bf16_t* wgt = (LAS const bf16_t*)(lds + L_WG); LAS const float* bgs = (LAS const float*)(lds + L_BG); LAS float* tot = (LAS float*)(lds + L_TOT);
        {
            const int lane = tid & 63, wave = tid >> 6; (void)lra;
            bf16x8 a; { const u32x4 w = R.lrf; a = __builtin_bit_cast(bf16x8, w); }
#pragma unroll
            for (int k = 0; k < 4; ++k) { const int t = wave + 8 * k, jt = t & 3, ct = t >> 2;
                const bf16x8 bq = *(LAS const bf16x8*)(wgt + (ct * 16 + (lane & 15)) * GS + (lane >> 4) * 8);
                f32x4 acc = {0.f, 0.f, 0.f, 0.f}; acc = __builtin_amdgcn_mfma_f32_16x16x32_bf16(a, bq, acc, 0, 0, 0);
                const int c = ct * 16 + (lane & 15); const float bias = bgs[c]; LAS float* dst = (c < 64 ? bf : bb) + (c & 63);
#pragma unroll
                for (int r = 0; r < 4; ++r) { const float x = acc[r] + bias; dst[(jt * 16 + (lane >> 4) * 4 + r) * 65] = (fminf(x, 0.f) - __logf(1.0f + __expf(-fabsf(x)))) * 0.0625f; } }
        }
        lds_barrier();
        {
            const int d = tid & 63, s8 = tid >> 6; float run = 0.f;
#pragma unroll
            for (int jj = 0; jj < 8; ++jj) { run += bf[(s8 * 8 + jj) * 65 + d]; bf[(s8 * 8 + jj) * 65 + d] = run; }
            tot[s8 * 64 + d] = run; run = 0.f;
#pragma unroll
            for (int jj = 7; jj >= 0; --jj) { run += bb[(s8 * 8 + jj) * 65 + d]; bb[(s8 * 8 + jj) * 65 + d] = run; }
            tot[512 + s8 * 64 + d] = run;
            lds_barrier();
            float of = 0.f, ob = 0.f;
#pragma unroll
            for (int s = 0; s < 8; ++s) { if (s < s8) of += tot[s * 64 + d]; if (s > s8) ob += tot[512 + s * 64 + d]; }
#pragma unroll
            for (int jj = 0; jj < 8; ++jj) { bf[(s8 * 8 + jj) * 65 + d] += of; bb[(s8 * 8 + jj) * 65 + d] += ob; }
        }
        lds_barrier();
    }
}

template <int DV, bool GATED>
__device__ __forceinline__ void bla_stage1(LAS unsigned char* lds, const Bla<DV, GATED>& P, int unit, const BlaRegs<DV, GATED, false>& R, int tid) {
    const int b = unit >> 8, n = (unit >> 2) & 63, h = unit & 3;
    const int lane = tid & 63, wave = tid >> 6, j = tid >> 3, sg = tid & 7;
    LAS float* bf = (LAS float*)(lds + L_BF); LAS float* bb = (LAS float*)(lds + L_BB); LAS bf16_t* vT = (LAS bf16_t*)(lds + L_VT);
    float klo[4], khi[4], qlo[4], qhi[4];
    bla_front<DV, GATED, false>(lds, R, n, h, tid, klo, khi, qlo, qhi);
    const float lgam = __logf(1.0f - __builtin_amdgcn_exp2f(-5.0f - (float)h)), cf = __expf((float)(63 - j) * lgam), cb = __expf((float)j * lgam);
    constexpr int KS = 80;
    LAS bf16_t* ksf = (LAS bf16_t*)(lds + L_QIN); LAS bf16_t* ksb = (LAS bf16_t*)(lds + L_QIN + 10240);
#pragma unroll
    for (int half = 0; half < 2; ++half) { float vf[4], vb[4];
#pragma unroll
        for (int e = 0; e < 4; ++e) { const int d = half * 32 + sg * 4 + e; const float kv = half ? khi[e] : klo[e];
            vf[e] = kv * (GATED ? __expf(bf[63 * 65 + d] - bf[j * 65 + d]) : cf); vb[e] = kv * (GATED ? __expf(bb[d] - bb[j * 65 + d]) : cb); }
        u32x2 wf, wb; wf.x = pk2(vf[0], vf[1]); wf.y = pk2(vf[2], vf[3]); wb.x = pk2(vb[0], vb[1]); wb.y = pk2(vb[2], vb[3]);
        *(LAS u32x2*)(ksf + j * KS + half * 32 + sg * 4) = wf; *(LAS u32x2*)(ksb + j * KS + half * 32 + sg * 4) = wb; }
    if (GATED && tid < 128) { const int dir = tid >> 6, d = tid & 63; P.dec[((size_t)((b * 4 + h) * 2 + dir) * 64 + n) * 64 + d] = __expf(dir ? bb[d] : bf[63 * 65 + d]); }
    lds_barrier();
    constexpr int NT = DV / 32, RSV = DV + 16;
    {
        const int g = lane >> 4, q = (lane & 15) >> 2, p = lane & 3, dt4 = wave & 3;
        const unsigned vaddr = (unsigned)(unsigned long long)(vT) + (unsigned)(((8 * g + q) * RSV + (wave >> 2) * 16 + 4 * p) * 2);
        const unsigned aaddr_f = (unsigned)(unsigned long long)(ksf) + (unsigned)(((8 * g + q) * KS + dt4 * 16 + 4 * p) * 2), aaddr_b = aaddr_f + 10240u;
        u32x2 bq[NT][2][2], af[2][2], ab[2][2];
        if constexpr (DV == 128) { asm volatile("ds_read_b64_tr_b16 %0, %20 offset:0\n\t" "ds_read_b64_tr_b16 %1, %20 offset:1152\n\t" "ds_read_b64_tr_b16 %2, %20 offset:9216\n\t" "ds_read_b64_tr_b16 %3, %20 offset:10368\n\t" "ds_read_b64_tr_b16 %4, %20 offset:64\n\t" "ds_read_b64_tr_b16 %5, %20 offset:1216\n\t" "ds_read_b64_tr_b16 %6, %20 offset:9280\n\t" "ds_read_b64_tr_b16 %7, %20 offset:10432\n\t" "ds_read_b64_tr_b16 %8, %20 offset:128\n\t" "ds_read_b64_tr_b16 %9, %20 offset:1280\n\t" "ds_read_b64_tr_b16 %10, %20 offset:9344\n\t" "ds_read_b64_tr_b16 %11, %20 offset:10496\n\t" "ds_read_b64_tr_b16 %12, %20 offset:192\n\t" "ds_read_b64_tr_b16 %13, %20 offset:1344\n\t" "ds_read_b64_tr_b16 %14, %20 offset:9408\n\t" "ds_read_b64_tr_b16 %15, %20 offset:10560\n\t" "ds_read_b64_tr_b16 %16, %21 offset:0\n\t" "ds_read_b64_tr_b16 %17, %21 offset:640\n\t" "ds_read_b64_tr_b16 %18, %21 offset:5120\n\t" "ds_read_b64_tr_b16 %19, %21 offset:5760\n\t" "s_waitcnt lgkmcnt(0)" : "=&v"(bq[0][0][0]), "=&v"(bq[0][0][1]), "=&v"(bq[0][1][0]), "=&v"(bq[0][1][1]), "=&v"(bq[1][0][0]), "=&v"(bq[1][0][1]), "=&v"(bq[1][1][0]), "=&v"(bq[1][1][1]), "=&v"(bq[2][0][0]), "=&v"(bq[2][0][1]), "=&v"(bq[2][1][0]), "=&v"(bq[2][1][1]), "=&v"(bq[3][0][0]), "=&v"(bq[3][0][1]), "=&v"(bq[3][1][0]), "=&v"(bq[3][1][1]), "=&v"(af[0][0]), "=&v"(af[0][1]), "=&v"(af[1][0]), "=&v"(af[1][1]) : "v"(vaddr), "v"(aaddr_f) : "memory");
            asm volatile("ds_read_b64_tr_b16 %0, %4 offset:0\n\t" "ds_read_b64_tr_b16 %1, %4 offset:640\n\t" "ds_read_b64_tr_b16 %2, %4 offset:5120\n\t" "ds_read_b64_tr_b16 %3, %4 offset:5760\n\t" "s_waitcnt lgkmcnt(0)" : "=&v"(ab[0][0]), "=&v"(ab[0][1]), "=&v"(ab[1][0]), "=&v"(ab[1][1]) : "v"(aaddr_b) : "memory"); }
        else { asm volatile("ds_read_b64_tr_b16 %0, %12 offset:0\n\t" "ds_read_b64_tr_b16 %1, %12 offset:640\n\t" "ds_read_b64_tr_b16 %2, %12 offset:5120\n\t" "ds_read_b64_tr_b16 %3, %12 offset:5760\n\t" "ds_read_b64_tr_b16 %4, %12 offset:64\n\t" "ds_read_b64_tr_b16 %5, %12 offset:704\n\t" "ds_read_b64_tr_b16 %6, %12 offset:5184\n\t" "ds_read_b64_tr_b16 %7, %12 offset:5824\n\t" "ds_read_b64_tr_b16 %8, %13 offset:0\n\t" "ds_read_b64_tr_b16 %9, %13 offset:640\n\t" "ds_read_b64_tr_b16 %10, %13 offset:5120\n\t" "ds_read_b64_tr_b16 %11, %13 offset:5760\n\t" "s_waitcnt lgkmcnt(0)" : "=&v"(bq[0][0][0]), "=&v"(bq[0][0][1]), "=&v"(bq[0][1][0]), "=&v"(bq[0][1][1]), "=&v"(bq[1][0][0]), "=&v"(bq[1][0][1]), "=&v"(bq[1][1][0]), "=&v"(bq[1][1][1]), "=&v"(af[0][0]), "=&v"(af[0][1]), "=&v"(af[1][0]), "=&v"(af[1][1]) : "v"(vaddr), "v"(aaddr_f) : "memory");
            asm volatile("ds_read_b64_tr_b16 %0, %4 offset:0\n\t" "ds_read_b64_tr_b16 %1, %4 offset:640\n\t" "ds_read_b64_tr_b16 %2, %4 offset:5120\n\t" "ds_read_b64_tr_b16 %3, %4 offset:5760\n\t" "s_waitcnt lgkmcnt(0)" : "=&v"(ab[0][0]), "=&v"(ab[0][1]), "=&v"(ab[1][0]), "=&v"(ab[1][1]) : "v"(aaddr_b) : "memory"); }
#pragma unroll
        for (int dir = 0; dir < 2; ++dir) {
            bf16_t* stb = P.st + ((size_t)((b * 4 + h) * 2 + dir) * 64 + n) * (DV * 64);
#pragma unroll
            for (int k = 0; k < NT; ++k) { const int et = (wave >> 2) + 2 * k; f32x4 acc = {0.f, 0.f, 0.f, 0.f};
#pragma unroll
                for (int kb = 0; kb < 2; ++kb) { const u32x2 a0 = dir ? ab[kb][0] : af[kb][0], a1 = dir ? ab[kb][1] : af[kb][1];
                    const u32x4 aw = {a0.x, a0.y, a1.x, a1.y}, bw = {bq[k][kb][0].x, bq[k][kb][0].y, bq[k][kb][1].x, bq[k][kb][1].y};
                    acc = __builtin_amdgcn_mfma_f32_16x16x32_bf16(__builtin_bit_cast(bf16x8, aw), __builtin_bit_cast(bf16x8, bw), acc, 0, 0, 0); }
                u32x2 w; w.x = pk2(acc[0], acc[1]); w.y = pk2(acc[2], acc[3]);
                *(u32x2*)(stb + (et * 16 + (lane & 15)) * 64 + dt4 * 16 + (lane >> 4) * 4) = w; }
        }
    }
    lds_barrier();
}

template <int DV, bool GATED>
__device__ __forceinline__ void bla_stage2(LAS unsigned char* lds, const Bla<DV, GATED>& P, int unit, const BlaRegs<DV, GATED, true>& R, int tid) {
    const int b = unit >> 8, n = (unit >> 2) & 63, h = unit & 3;
    const int lane = tid & 63, wave = tid >> 6, j = tid >> 3, sg = tid & 7; const int tok0 = b * SEQ + n * 64;
    LAS float* bf = (LAS float*)(lds + L_BF); LAS float* bb = (LAS float*)(lds + L_BB); LAS bf16_t* vT = (LAS bf16_t*)(lds + L_VT);
    LAS bf16_t* qin = (LAS bf16_t*)(lds + L_QIN); LAS bf16_t* kin = (LAS bf16_t*)(lds + L_KIN); LAS bf16_t* Pm = (LAS bf16_t*)(lds + L_P); LAS bf16_t* ST = (LAS bf16_t*)(lds + L_ST);
    float klo[4], khi[4], qlo[4], qhi[4];
    bla_front<DV, GATED, true>(lds, R, n, h, tid, klo, khi, qlo, qhi);
    const float lgam = __logf(1.0f - __builtin_amdgcn_exp2f(-5.0f - (float)h));
    constexpr int NT = DV / 32;
    f32x4 oacc[NT];
#pragma unroll
    for (int k = 0; k < NT; ++k) oacc[k] = (f32x4){0.f, 0.f, 0.f, 0.f};
    constexpr bool BOTH = !GATED;
    LAS bf16_t* const qin2[2] = {qin, BOTH ? (LAS bf16_t*)(lds + L_BF) : qin};
    LAS bf16_t* const kin2[2] = {kin, BOTH ? (LAS bf16_t*)(lds + L_BF + 9216) : kin};
    LAS bf16_t* const Pm2[2] = {Pm, BOTH ? (LAS bf16_t*)(lds + L_BF + 18432) : Pm};
    LAS bf16_t* const ST2[2] = {ST, BOTH ? ST + 64 * RS : ST};
#define BLA_STEP_A(dir) do { LAS const float* bx = (dir) ? bb : bf; \
        const float bret = (float)((dir) ? 64 - j : j + 1) * lgam, eq = __expf(bret), ek = __expf(-bret); \
        _Pragma("unroll") for (int half = 0; half < 2; ++half) { float qv[4], kv4[4]; \
            _Pragma("unroll") for (int e = 0; e < 4; ++e) { const int d = half * 32 + sg * 4 + e; \
                if (GATED) { const float bv = bx[j * 65 + d]; qv[e] = (half ? qhi[e] : qlo[e]) * __expf(bv); kv4[e] = (half ? khi[e] : klo[e]) * __expf(-bv); } \
                else { qv[e] = (half ? qhi[e] : qlo[e]) * eq; kv4[e] = (half ? khi[e] : klo[e]) * ek; } } \
            u32x2 wq, wk; wq.x = pk2(qv[0], qv[1]); wq.y = pk2(qv[2], qv[3]); wk.x = pk2(kv4[0], kv4[1]); wk.y = pk2(kv4[2], kv4[3]); \
            *(LAS u32x2*)(qin2[dir] + j * RS + half * 32 + sg * 4) = wq; *(LAS u32x2*)(kin2[dir] + j * RS + half * 32 + sg * 4) = wk; } \
        _Pragma("unroll") for (int q = 0; q < DV / 64; ++q) { const int sgi = tid + 512 * q, e = sgi >> 3, d8 = (sgi & 7) * 8; *(LAS u32x4*)(ST2[dir] + e * RS + d8) = R.st[dir][q]; } } while (0)
#define BLA_STEP_B(dir) do { \
        _Pragma("unroll") for (int k = 0; k < 2; ++k) { const int t = wave + 8 * k, it = t & 3, jt = t >> 2; f32x4 acc = {0.f, 0.f, 0.f, 0.f}; \
            _Pragma("unroll") for (int kb = 0; kb < 2; ++kb) acc = __builtin_amdgcn_mfma_f32_16x16x32_bf16(frag(qin2[dir], it * 16, kb, lane), frag(kin2[dir], jt * 16, kb, lane), acc, 0, 0, 0); \
            const int jj = jt * 16 + (lane & 15); \
            _Pragma("unroll") for (int r = 0; r < 4; ++r) { const int ii = it * 16 + (lane >> 4) * 4 + r; const bool keep = (dir) ? (jj > ii) : (jj <= ii); Pm2[dir][ii * RS + jj] = (bf16_t)f2bf(keep ? acc[r] : 0.f); } } } while (0)
#define BLA_STEP_C(dir) do { \
        _Pragma("unroll") for (int k = 0; k < NT; ++k) { const int t = wave + 8 * k, it = t & 3, et = t >> 2; \
            _Pragma("unroll") for (int kb = 0; kb < 2; ++kb) oacc[k] = __builtin_amdgcn_mfma_f32_16x16x32_bf16(frag(Pm2[dir], it * 16, kb, lane), frag(vT, et * 16, kb, lane), oacc[k], 0, 0, 0); \
            _Pragma("unroll") for (int kb = 0; kb < 2; ++kb) oacc[k] = __builtin_amdgcn_mfma_f32_16x16x32_bf16(frag(qin2[dir], it * 16, kb, lane), frag(ST2[dir], et * 16, kb, lane), oacc[k], 0, 0, 0); } } while (0)
    if constexpr (BOTH) {
        BLA_STEP_A(0); BLA_STEP_A(1); lds_barrier();
        BLA_STEP_B(0); BLA_STEP_B(1); lds_barrier();
        BLA_STEP_C(0); BLA_STEP_C(1); lds_barrier();
    } else {
        BLA_STEP_A(0); lds_barrier(); BLA_STEP_B(0); lds_barrier(); BLA_STEP_C(0); lds_barrier();
        BLA_STEP_A(1); lds_barrier(); BLA_STEP_B(1); lds_barrier(); BLA_STEP_C(1); lds_barrier();
    }
#undef BLA_STEP_A
#undef BLA_STEP_B
#undef BLA_STEP_C
    constexpr int OS = DV + 4; LAS float* ob = (LAS float*)lds; LAS const float* ngs = (LAS const float*)(lds + L_NG);
#pragma unroll
    for (int k = 0; k < NT; ++k) { const int t = wave + 8 * k, it = t & 3, et = t >> 2;
#pragma unroll
        for (int r = 0; r < 4; ++r) ob[(it * 16 + (lane >> 4) * 4 + r) * OS + et * 16 + (lane & 15)] = oacc[k][r]; }
    lds_barrier();
    {
        constexpr int NV = DV / 8; float v[NV]; float s = 0.f;
#pragma unroll
        for (int e = 0; e < NV; ++e) { v[e] = ob[j * OS + sg * NV + e]; s += v[e]; }
        if (!GATED) { s += shx(s, 1, lane); s += shx(s, 2, lane); s += shx(s, 4, lane); const float mean = s * (1.0f / DV);
#pragma unroll
            for (int e = 0; e < NV; ++e) v[e] -= mean; }
        float q = 0.f;
#pragma unroll
        for (int e = 0; e < NV; ++e) q += v[e] * v[e];
        q += shx(q, 1, lane); q += shx(q, 2, lane); q += shx(q, 4, lane);
        const float rs = __builtin_amdgcn_rsqf(q * (1.0f / DV) + EPS);
        bf16_t* op = P.out + (size_t)(tok0 + j) * P.ldo + h * DV + sg * NV;
#pragma unroll
        for (int q8 = 0; q8 < NV / 8; ++q8) { const u32x4 gw = R.og[q8]; float gt[8];
            gt[0] = bf2f(gw.x & 0xffffu); gt[1] = bf2f(gw.x >> 16); gt[2] = bf2f(gw.y & 0xffffu); gt[3] = bf2f(gw.y >> 16); gt[4] = bf2f(gw.z & 0xffffu); gt[5] = bf2f(gw.z >> 16); gt[6] = bf2f(gw.w & 0xffffu); gt[7] = bf2f(gw.w >> 16);
            float r[8];
#pragma unroll
            for (int e = 0; e < 8; ++e) { const float y = v[q8 * 8 + e] * rs * ngs[sg * NV + q8 * 8 + e]; r[e] = y * gt[e] * sigmoidf_(gt[e]); }
            u32x4 w; w.x = pk2(r[0], r[1]); w.y = pk2(r[2], r[3]); w.z = pk2(r[4], r[5]); w.w = pk2(r[6], r[7]);
            *(u32x4*)(op + q8 * 8) = w; }
    }
    lds_barrier();
}
template <int DV, bool GATED>
__device__ __forceinline__ void bla_phase1(LAS unsigned char* lds, const Bla<DV, GATED>& P, const int wv) {
    const int tid = ltid(wv), G = lgdim(); int u = lbid(), hl = -1;
    BlaRegs<DV, GATED, false> cur, nx1, nx2;
    if (u < 4096) bla_issue<DV, GATED, false>(P, u, tid, cur);
    if (u + G < 4096) bla_issue<DV, GATED, false>(P, u + G, tid, nx1);
    for (; u < 4096; u += G) {
        if (u + 2 * G < 4096) bla_issue<DV, GATED, false>(P, u + 2 * G, tid, nx2);
        if ((u & 3) != hl) { hl = u & 3; bla_head_consts<DV, GATED>(lds, P, hl, tid); }
        bla_stage1<DV, GATED>(lds, P, u, cur, tid);
        cur = nx1; nx1 = nx2;
    }
}
template <int DV, bool GATED>
__device__ __forceinline__ void bla_phase2(LAS unsigned char* lds, const Bla<DV, GATED>& P, const int wv) {
    const int tid = ltid(wv), G = lgdim(); int u = lbid(), hl = -1;
    BlaRegs<DV, GATED, true> cur, nx1, nx2;
    if (u < 4096) bla_issue<DV, GATED, true>(P, u, tid, cur);
    if (u + G < 4096) bla_issue<DV, GATED, true>(P, u + G, tid, nx1);
    for (; u < 4096; u += G) {
        if (u + 2 * G < 4096) bla_issue<DV, GATED, true>(P, u + 2 * G, tid, nx2);
        if ((u & 3) != hl) { hl = u & 3; bla_head_consts<DV, GATED>(lds, P, hl, tid); }
        bla_stage2<DV, GATED>(lds, P, u, cur, tid);
        cur = nx1; nx1 = nx2;
    }
}

__device__ __forceinline__ void bla_scan_pair(int gi, int ri, int si, bf16_t* gst, const float* gdec, bf16_t* rst, const S5In p, int l, const float* Xl, bf16_t* Uc) {
    const int gd8 = gi & 7, ge = (gi >> 3) & 127, gbhd = gi >> 10, gdir = gbhd & 1;
    bf16_t* gbase = gst + (size_t)gbhd * 64 * 128 * 64 + ge * 64 + gd8 * 8; const float* dbase = gdec + (size_t)gbhd * 64 * 64 + gd8 * 8;
    const bool hasr = ri >= 0; const int rr = hasr ? ri : 0;
    const int rd8 = rr & 7, re = (rr >> 3) & 63, rbhd = rr >> 9, rdir = rbhd & 1, rh = (rbhd >> 1) & 3;
    bf16_t* rbase = rst + (size_t)rbhd * 64 * 64 * 64 + re * 64 + rd8 * 8;
    const float cdec = __expf(64.0f * __logf(1.0f - __builtin_amdgcn_exp2f(-5.0f - (float)rh)));
    float S[8], T[8];
#pragma unroll
    for (int k = 0; k < 8; ++k) { S[k] = 0.f; T[k] = 0.f; }
    const bool hass = si >= 0; const int sx = hass ? si : 0;
    const int spp = sx & 63, sdir = (sx >> 6) & 1, sg5 = (sx >> 7) & 15, sb = sx >> 11;
    float Lr = 0.f, Li = 0.f, xr = 0.f, xi = 0.f;
    if (hass) { const float lr = p.lam_re[(size_t)l * 2048 + (sdir * 16 + sg5) * 64 + spp], li = p.lam_im[(size_t)l * 2048 + (sdir * 16 + sg5) * 64 + spp], dt = __expf(p.log_dt[l * 32 + sdir * 16 + sg5]);
        const float mag = __expf(lr * dt * 64.f); float sn, cs; sincos_turns((double)li * (double)dt * 64.0 * INV2PI, sn, cs); Lr = mag * cs; Li = mag * sn; }
    const size_t srow0 = (size_t)sg5 * 1024 + sb * 64;
#pragma unroll 1
    for (int bt = 0; bt < 8; ++bt) {
        u32x4 kw[8], rw[8]; f32x4 d0[8], d1[8];
#pragma unroll
        for (int s = 0; s < 8; ++s) { const int stp = bt * 8 + s, n = gdir ? 63 - stp : stp, nr = rdir ? 63 - stp : stp;
            kw[s] = *(const u32x4*)(gbase + (size_t)n * 8192); d0[s] = *(const f32x4*)(dbase + n * 64); d1[s] = *(const f32x4*)(dbase + n * 64 + 4);
            rw[s] = hasr ? *(const u32x4*)(rbase + (size_t)nr * 4096) : (u32x4){0u, 0u, 0u, 0u}; }
        float ar[8], ai[8];
#pragma unroll
        for (int s = 0; s < 8; ++s) { const int stp = bt * 8 + s, n5 = sdir ? 63 - stp : stp; ar[s] = hass ? Xl[(srow0 + n5) * 256 + sdir * 128 + spp] : 0.f; ai[s] = hass ? Xl[(srow0 + n5) * 256 + sdir * 128 + 64 + spp] : 0.f; }
#pragma unroll
        for (int s = 0; s < 8; ++s) { const int stp = bt * 8 + s, n = gdir ? 63 - stp : stp, nr = rdir ? 63 - stp : stp;
            { u32x4 w; w.x = pk2(S[0], S[1]); w.y = pk2(S[2], S[3]); w.z = pk2(S[4], S[5]); w.w = pk2(S[6], S[7]); *(u32x4*)(gbase + (size_t)n * 8192) = w; }
            const u32x4 k4 = kw[s];
            S[0] = d0[s][0] * S[0] + bf2f(k4.x & 0xffffu); S[1] = d0[s][1] * S[1] + bf2f(k4.x >> 16); S[2] = d0[s][2] * S[2] + bf2f(k4.y & 0xffffu); S[3] = d0[s][3] * S[3] + bf2f(k4.y >> 16);
            S[4] = d1[s][0] * S[4] + bf2f(k4.z & 0xffffu); S[5] = d1[s][1] * S[5] + bf2f(k4.z >> 16); S[6] = d1[s][2] * S[6] + bf2f(k4.w & 0xffffu); S[7] = d1[s][3] * S[7] + bf2f(k4.w >> 16);
            if (hasr) { u32x4 w; w.x = pk2(T[0], T[1]); w.y = pk2(T[2], T[3]); w.z = pk2(T[4], T[5]); w.w = pk2(T[6], T[7]); *(u32x4*)(rbase + (size_t)nr * 4096) = w;
                const u32x4 r4 = rw[s];
                T[0] = cdec * T[0] + bf2f(r4.x & 0xffffu); T[1] = cdec * T[1] + bf2f(r4.x >> 16); T[2] = cdec * T[2] + bf2f(r4.y & 0xffffu); T[3] = cdec * T[3] + bf2f(r4.y >> 16);
                T[4] = cdec * T[4] + bf2f(r4.z & 0xffffu); T[5] = cdec * T[5] + bf2f(r4.z >> 16); T[6] = cdec * T[6] + bf2f(r4.w & 0xffffu); T[7] = cdec * T[7] + bf2f(r4.w >> 16); }
            if (hass) { const int n5 = sdir ? 63 - stp : stp;
                Uc[(srow0 + n5) * 1280 + 1024 + sdir * 128 + spp] = (bf16_t)f2bf(xr); Uc[(srow0 + n5) * 1280 + 1024 + sdir * 128 + 64 + spp] = (bf16_t)f2bf(xi);
                const float nr2 = Lr * xr - Li * xi + ar[s], ni2 = Lr * xi + Li * xr + ai[s]; xr = nr2; xi = ni2; } }
    }
}
__device__ __forceinline__ void s5_scan_item(const S5In p, int l, int idx, const float* Xl, bf16_t* Uc) {
    const int pp = idx & 63, dir = (idx >> 6) & 1, g = (idx >> 7) & 15, b = idx >> 11;
    const float lr = p.lam_re[(size_t)l * 2048 + (dir * 16 + g) * 64 + pp], li = p.lam_im[(size_t)l * 2048 + (dir * 16 + g) * 64 + pp], dt = __expf(p.log_dt[l * 32 + dir * 16 + g]);
    const float mag = __expf(lr * dt * 64.f); float s, cs; sincos_turns((double)li * (double)dt * 64.0 * INV2PI, s, cs);
    const float Lr = mag * cs, Li = mag * s; float xr = 0.f, xi = 0.f;
    const size_t row0 = (size_t)g * 1024 + b * 64;
#pragma unroll 1
    for (int bt = 0; bt < 4; ++bt) { float ar[16], ai[16];
#pragma unroll
        for (int q = 0; q < 16; ++q) { const int st = bt * 16 + q, n = dir ? 63 - st : st; ar[q] = Xl[(row0 + n) * 256 + dir * 128 + pp]; ai[q] = Xl[(row0 + n) * 256 + dir * 128 + 64 + pp]; }
#pragma unroll
        for (int q = 0; q < 16; ++q) { const int st = bt * 16 + q, n = dir ? 63 - st : st;
            Uc[(row0 + n) * 1280 + 1024 + dir * 128 + pp] = (bf16_t)f2bf(xr); Uc[(row0 + n) * 1280 + 1024 + dir * 128 + 64 + pp] = (bf16_t)f2bf(xi);
            const float nr = Lr * xr - Li * xi + ar[q], ni = Lr * xi + Li * xr + ai[q]; xr = nr; xi = ni; } }
}
__device__ __forceinline__ void scan_phase(const S5In p, int l, const float* Xl, bf16_t* Uc, bf16_t* gst, const float* gdec, bf16_t* rst, const int wv) {
    const int tid = ltid(wv), G = lgdim(), blk = lbid();
    for (int base = blk; base < 256; base += G) {
        const int gi = base * 512 + tid, ri = tid < 256 ? base * 256 + tid : -1;
        bla_scan_pair(gi, ri, tid >= 384 ? base * 128 + (tid - 384) : -1, gst, gdec, rst, p, l, Xl, Uc);
    }
}

typedef const Params __attribute__((address_space(4)))* PP;
__device__ __forceinline__ PP fresh_params() {
    unsigned long long ka = (unsigned long long)__builtin_amdgcn_kernarg_segment_ptr();
    asm volatile("" : "+s"(ka));
    return (PP)ka;
}
#define WSP(T, off) ((T*)(pp->ws + (off)))
#define XB_TMO      128
#define XB_XCNT(j)  (256  + 64 * (j))
#define XB_XSUB(j)  (1280 + 64 * (j))
#define XB_XGEN(j)  (2304 + 64 * (j))
#define XB_TOP      3328
#define XB_TOPGEN   3392
#define XCD_BAR_WORDS 3456
#define XB_SPIN_CAP (1u << 18)
__device__ __forceinline__ unsigned xb_ld(unsigned* p)              { return __hip_atomic_load(p, __ATOMIC_RELAXED, __HIP_MEMORY_SCOPE_AGENT); }
__device__ __forceinline__ unsigned xb_add(unsigned* p, unsigned v) { return __hip_atomic_fetch_add(p, v, __ATOMIC_RELAXED, __HIP_MEMORY_SCOPE_AGENT); }
__device__ __forceinline__ unsigned xb_xcc_id() { return (unsigned)__builtin_amdgcn_s_getreg((3 << 11) | 20) & 0xFu; }
#define XB_SPIN(cond, bar) do { unsigned _sp = 0; while (cond) { __builtin_amdgcn_s_sleep(1); \
    if ((++_sp & 255u) == 0u) { if (xb_ld(&(bar)[XB_TMO])) break; if (_sp > XB_SPIN_CAP) { atomicAdd(&(bar)[XB_TMO], 1u); break; } } } } while (0)
__device__ __forceinline__ void xcd_barrier_complete(unsigned* bar, unsigned x, unsigned G, unsigned& nloc, unsigned& nx) {
    unsigned sum, cnt, mine, sp = 0u;
    for (;;) {
        sum = 0u; cnt = 0u; mine = 0u;
#pragma unroll
        for (unsigned j = 0; j < 16; ++j) { const unsigned c = xb_ld(&bar[XB_XCNT(j)]); sum += c; cnt += (c > 0u) ? 1u : 0u; mine = (j == x) ? c : mine; }
        if (sum == G) break;
        __builtin_amdgcn_s_sleep(1);
        if ((++sp & 255u) == 0u) { if (xb_ld(&bar[XB_TMO])) break; if (sp > XB_SPIN_CAP) { atomicAdd(&bar[XB_TMO], 1u); break; } }
    }
    nloc = mine > 0u ? mine : 1u; nx = cnt > 0u ? cnt : 1u;
}
__device__ __forceinline__ void grid_barrier(unsigned* bar, volatile LAS unsigned* st, const int wv) {
    asm volatile("s_waitcnt vmcnt(0) lgkmcnt(0)" ::: "memory");
    __syncthreads();
    if (ltid(wv) == 0) {
        const unsigned x = xb_xcc_id();
        __builtin_amdgcn_s_waitcnt(0);
        unsigned nloc = st[0], nx = st[1];
        if (nloc == 0u) { xcd_barrier_complete(bar, x, (unsigned)lgdim(), nloc, nx); st[0] = nloc; st[1] = nx; }
        const unsigned old = xb_add(&bar[XB_XSUB(x)], 1u);
        const unsigned gen = old / nloc;
        if (old + 1u == (gen + 1u) * nloc) {
            __builtin_amdgcn_fence(__ATOMIC_RELEASE, "agent");
            asm volatile("s_waitcnt vmcnt(0)" ::: "memory");
            const unsigned og = xb_add(&bar[XB_TOP], 1u);
            const unsigned tg = og / nx;
            if (og + 1u == (tg + 1u) * nx) xb_add(&bar[XB_TOPGEN], 1u);
            else XB_SPIN(xb_ld(&bar[XB_TOPGEN]) == tg, bar);
            __builtin_amdgcn_fence(__ATOMIC_ACQUIRE, "agent");
            xb_add(&bar[XB_XGEN(x)], 1u);
            asm volatile("s_waitcnt vmcnt(0)" ::: "memory");
        } else {
            XB_SPIN(xb_ld(&bar[XB_XGEN(x)]) == gen, bar);
            __builtin_amdgcn_fence(__ATOMIC_ACQUIRE, "agent");
            asm volatile("s_waitcnt vmcnt(0)" ::: "memory");
        }
    }
    __syncthreads();
}
#define GSYNC(i) do { PP pq = fresh_params(); grid_barrier((unsigned*)(pq->ws + WS_CTL), (volatile LAS unsigned*)(lds + 131072), wv); } while (0)

__global__ void __launch_bounds__(512, 2) fwd_megakernel(Params p_unused) {
    extern __shared__ __attribute__((aligned(16))) unsigned char lds_raw[];
    LAS unsigned char* lds = (LAS unsigned char*)lds_raw;
    const int wv = __builtin_amdgcn_readfirstlane((int)(threadIdx.x >> 6));
    if (threadIdx.x < 4) ((volatile LAS unsigned*)(lds + 131072))[threadIdx.x] = 0u;
    if (blockIdx.x == 0) { PP pz = fresh_params(); unsigned* bz = (unsigned*)(pz->ws + WS_CTL);
        for (int i = threadIdx.x; i < XCD_BAR_WORDS; i += 512) __hip_atomic_store(bz + i, 0u, __ATOMIC_RELAXED, __HIP_MEMORY_SCOPE_AGENT); }
    cg::this_grid().sync();
    if (threadIdx.x == 0) { PP pz = fresh_params(); (void)xb_add((unsigned*)(pz->ws + WS_CTL) + XB_XCNT(xb_xcc_id()), 1u); }

#pragma unroll 1
    for (int l = 0; l < DEPTH; ++l) {
#if !defined(NO_CONV)
        { PP pp = fresh_params(); conv_T(lds, pp->in[2] + (size_t)l * DM * 2832, DM, 2832, WSP(bf16_t, WS_WZ), 3072, MapZ(), wv); }
        { PP pp = fresh_params(); conv_T(lds, pp->in[18] + (size_t)l * DM * 3072, DM, 3072, WSP(bf16_t, WS_WG), 3072, MapId(), wv); }
        { PP pp = fresh_params(); conv_T(lds, pp->in[15] + (size_t)l * 256 * DM, 256, DM, WSP(bf16_t, WS_WA), DM, MapId(), wv); }
        { PP pp = fresh_params(); conv_T(lds, pp->in[16] + (size_t)l * 256 * 2048, 256, 2048, WSP(bf16_t, WS_WB), 2048, MapGLU(), wv); }
        { PP pp = fresh_params(); conv_T(lds, pp->in[17] + (size_t)l * 512 * DM, 512, DM, WSP(bf16_t, WS_WC), DM, MapId(), wv); }
        { PP pp = fresh_params(); conv_T(lds, pp->in[20] + (size_t)l * DM * DM, DM, DM, WSP(bf16_t, WS_WO), DM, MapId(), wv); }
        { PP pp = fresh_params(); conv_T(lds, pp->in[22] + (size_t)l * DM * DFF, DM, DFF, WSP(bf16_t, WS_W1), DFF, MapId(), wv); }
        { PP pp = fresh_params(); conv_T(lds, pp->in[23] + (size_t)l * DFF * DM, DFF, DM, WSP(bf16_t, WS_W2), DM, MapId(), wv); }
#endif
#if !defined(NO_PREP)
        { PP pp = fresh_params(); const S5In si{pp->in[4], pp->in[5], pp->in[6], pp->in[7], pp->in[8], pp->in[9], pp->in[10], pp->in[11]}; for (int u = lbid(); u < 256; u += lgdim()) s5_prep(lds, si, l, u, WSP(bf16_t, WS_T1), WSP(bf16_t, WS_T2), wv); }
#endif
        { PP pp = fresh_params(); if (l == 0) prep0_phase(pp->in[0], pp->in[1], WSP(bf16_t, WS_H), WSP(float, WS_RS1), wv); else rs_phase(WSP(float, WS_SL1), WSP(float, WS_RS1), wv); }
        GSYNC(0);
        { PP pp = fresh_params(); pg8::OrderStd S; S.init(WSP(bf16_t, WS_H), DM, WSP(bf16_t, WS_WZ), DM, NTOK, 3072); pg8::EpiZ E{WSP(bf16_t, WS_Z), WSP(bf16_t, WS_UC), WSP(float, WS_RS1)}; pg8::gemm_phase(lds, S, E, DM, DM, DM, wv); }
        GSYNC(1);
        { PP pp = fresh_params(); pg8::OrderBatch S; S.init(WSP(bf16_t, WS_UC), 1280, (size_t)1024 * 1280 * 2, WSP(bf16_t, WS_T1), 1024, (size_t)256 * 1024 * 2, 4, 1); pg8::EpiXloc E{WSP(float, WS_XL)}; pg8::gemm_phase(lds, S, E, 1024, 1280, 1024, wv); }
#if !defined(NO_BLA1)
        { PP pp = fresh_params(); Bla<64, false> PA{WSP(bf16_t, WS_Z) + ZR_OFF, nullptr, nullptr, nullptr, WSP(bf16_t, WS_RST), nullptr, pp->in[3] + l * 256, WSP(bf16_t, WS_RO), 256};
          bla_phase1<64, false>(lds, PA, wv); }
        { PP pp = fresh_params(); Bla<128, true> PC{WSP(bf16_t, WS_Z) + ZG_OFF, WSP(bf16_t, WS_Z) + ZL_OFF, pp->in[12] + (size_t)l * 2 * 16 * 256, pp->in[13] + l * 512, WSP(bf16_t, WS_GST), WSP(float, WS_GDEC), pp->in[14] + l * 512, WSP(bf16_t, WS_GO), 512};
          bla_phase1<128, true>(lds, PC, wv); }
#endif
        GSYNC(2);
#if !defined(NO_SCAN)
        { PP pp = fresh_params(); const S5In si{pp->in[4], pp->in[5], pp->in[6], pp->in[7], pp->in[8], pp->in[9], pp->in[10], pp->in[11]}; scan_phase(si, l, WSP(float, WS_XL), WSP(bf16_t, WS_UC), WSP(bf16_t, WS_GST), WSP(float, WS_GDEC), WSP(bf16_t, WS_RST), wv); }
#endif
        GSYNC(3);
        { PP pp = fresh_params(); pg8::OrderBatch S; S.init(WSP(bf16_t, WS_UC), 1280, (size_t)1024 * 1280 * 2, WSP(bf16_t, WS_T2), 1280, (size_t)1024 * 1280 * 2, 4, 4); pg8::EpiS5Y E{WSP(bf16_t, WS_Y)}; pg8::gemm_phase(lds, S, E, 1280, 1280, 1280, wv); }
#if !defined(NO_BLA2)
        { PP pp = fresh_params(); Bla<64, false> PA{WSP(bf16_t, WS_Z) + ZR_OFF, nullptr, nullptr, nullptr, WSP(bf16_t, WS_RST), nullptr, pp->in[3] + l * 256, WSP(bf16_t, WS_RO), 256};
          bla_phase2<64, false>(lds, PA, wv); }
        { PP pp = fresh_params(); Bla<128, true> PC{WSP(bf16_t, WS_Z) + ZG_OFF, WSP(bf16_t, WS_Z) + ZL_OFF, pp->in[12] + (size_t)l * 2 * 16 * 256, pp->in[13] + l * 512, WSP(bf16_t, WS_GST), WSP(float, WS_GDEC), pp->in[14] + l * 512, WSP(bf16_t, WS_GO), 512};
          bla_phase2<128, true>(lds, PC, wv); }
#endif
        GSYNC(4);
        { PP pp = fresh_params(); pg8::OrderStd S; S.init(WSP(bf16_t, WS_RO), 256, WSP(bf16_t, WS_WA), 256, NTOK, DM); pg8::EpiBf16<0> E{WSP(bf16_t, WS_Z), DM, nullptr}; pg8::gemm_phase(lds, S, E, 256, 256, 256, wv); }
        { PP pp = fresh_params(); pg8::OrderStd S; S.init(WSP(bf16_t, WS_Y), 256, WSP(bf16_t, WS_WB), 256, NTOK, 2048); pg8::EpiGLU E{WSP(bf16_t, WS_Z) + (size_t)NTOK * DM}; pg8::gemm_phase(lds, S, E, 256, 256, 256, wv); }
        { PP pp = fresh_params(); pg8::OrderStd S; S.init(WSP(bf16_t, WS_GO), 512, WSP(bf16_t, WS_WC), 512, NTOK, DM); pg8::EpiBf16<0> E{WSP(bf16_t, WS_Z) + (size_t)2 * NTOK * DM, DM, nullptr}; pg8::gemm_phase(lds, S, E, 512, 512, 512, wv); }
        GSYNC(5);
        { PP pp = fresh_params(); pg8::OrderMerge S; S.init(WSP(bf16_t, WS_H), DM, WSP(bf16_t, WS_WG), DM, NTOK); pg8::EpiMerge E{WSP(bf16_t, WS_Z), WSP(bf16_t, WS_GST), pp->in[19] + (size_t)l * 3072, WSP(float, WS_RS1)}; pg8::gemm_phase(lds, S, E, DM, DM, DM, wv); }
        GSYNC(6);
        { PP pp = fresh_params(); pg8::OrderStd S; S.init(WSP(bf16_t, WS_GST), DM, WSP(bf16_t, WS_WO), DM, NTOK, DM); pg8::EpiResNorm E{l == 0 ? pp->in[0] : pp->out, pp->out, WSP(bf16_t, WS_H), pp->in[21] + l * DM, WSP(float, WS_SL2)}; pg8::gemm_phase(lds, S, E, DM, DM, DM, wv); }
        GSYNC(7);
        { PP pp = fresh_params(); rs_phase(WSP(float, WS_SL2), WSP(float, WS_RS2), wv); }
        GSYNC(8);
        { PP pp = fresh_params(); pg8::OrderStd S; S.init(WSP(bf16_t, WS_H), DM, WSP(bf16_t, WS_W1), DM, NTOK, DFF); pg8::EpiBf16<1> E{WSP(bf16_t, WS_Z), DFF, WSP(float, WS_RS2)}; pg8::gemm_phase(lds, S, E, DM, DM, DM, wv); }
        GSYNC(9);
        { PP pp = fresh_params(); pg8::OrderStd S; S.init(WSP(bf16_t, WS_Z), DFF, WSP(bf16_t, WS_W2), DFF, NTOK, DM); pg8::EpiResNorm E{pp->out, pp->out, l + 1 < DEPTH ? WSP(bf16_t, WS_H) : nullptr, pp->in[1] + (l + 1 < DEPTH ? (l + 1) * DM : 0), WSP(float, WS_SL1)}; pg8::gemm_phase(lds, S, E, DFF, DFF, DFF, wv); }
        GSYNC(10);
    }
    { PP pp = fresh_params(); final_norm_phase(pp->out, pp->in[24], WSP(float, WS_SL1), wv); }
}

extern "C" void kernel_launch(void* const* d_in, const int* in_sizes, int n_in, void* d_out, int out_size, void* d_ws, size_t ws_size, hipStream_t stream) {
    static int grid_blocks = 0;
    if (grid_blocks == 0) {
        if (n_in != 25 || out_size != NTOK * DM || ws_size < WS_END) { fprintf(stderr, "kernel_launch: unexpected shapes (n_in %d out %d ws %zu need %zu)\n", n_in, out_size, ws_size, (size_t)WS_END); grid_blocks = -1; return; }
        int dev = 0, cus = 0, per_cu = 0;
        (void)hipGetDevice(&dev);
        (void)hipDeviceGetAttribute(&cus, hipDeviceAttributeMultiprocessorCount, dev);
        (void)hipFuncSetAttribute((const void*)fwd_megakernel, hipFuncAttributeMaxDynamicSharedMemorySize, LDS_BYTES);
        (void)hipOccupancyMaxActiveBlocksPerMultiprocessor(&per_cu, (const void*)fwd_megakernel, 512, LDS_BYTES);
        if (per_cu < 1) { fprintf(stderr, "kernel_launch: occupancy query says %d blocks per CU\n", per_cu); per_cu = 1; }
        (void)hipGetLastError();
        grid_blocks = cus * per_cu;
        if (grid_blocks > 256) grid_blocks = 256;
    }
    if (grid_blocks < 0) return;
    Params p{};
    for (int i = 0; i < 25; ++i) p.in[i] = (const float*)d_in[i];
    p.out = (float*)d_out; p.ws = (unsigned char*)d_ws;
    void* args[] = {&p};
    hipError_t e = hipLaunchCooperativeKernel((const void*)fwd_megakernel, dim3(grid_blocks), dim3(512), args, LDS_BYTES, stream);
    if (e != hipSuccess) fprintf(stderr, "cooperative launch failed: %s (grid %d)\n", hipGetErrorString(e), grid_blocks);
}
```

```cpp
#include <hip/hip_runtime.h>
#include <hip/hip_cooperative_groups.h>
#include <cstdio>
#include <cstdint>
namespace cg = cooperative_groups;

#define LAS __attribute__((address_space(3)))
typedef unsigned short bf16_t;
typedef short bf16x8 __attribute__((ext_vector_type(8)));
typedef float f32x4 __attribute__((ext_vector_type(4)));
typedef float f32x2 __attribute__((ext_vector_type(2)));
typedef unsigned u32x4 __attribute__((ext_vector_type(4)));
typedef unsigned u32x2 __attribute__((ext_vector_type(2)));

#ifndef EN_A
#define EN_A 1
#endif
#ifndef EN_B
#define EN_B 1
#endif
#ifndef EN_C
#define EN_C 1
#endif

constexpr int NTOK = 65536, DM = 1024, SEQ = 4096, DEPTH = 4, DFF = 4096;
constexpr int ZS = 3072;
constexpr int C_RQ = 0, C_RK = 256, C_RV = 512, C_RG = 768, C_SU = 1024, C_GQ = 1280, C_GK = 1536, C_GV = 1792, C_GR = 2304, C_LR = 2816;
constexpr int LDS_BYTES = 131072 + 16;
constexpr size_t ZR_OFF = 0, ZG_OFF = (size_t)65536 * 1024, ZL_OFF = ZG_OFF + (size_t)65536 * 1536;
constexpr float EPS = 1e-6f;

constexpr size_t WS_WZ = 0;
constexpr size_t WS_WG = WS_WZ + 6291456;
constexpr size_t WS_WA = WS_WG + 6291456;
constexpr size_t WS_WB = WS_WA + 524288;
constexpr size_t WS_WC = WS_WB + 1048576;
constexpr size_t WS_WO = WS_WC + 1048576;
constexpr size_t WS_W1 = WS_WO + 2097152;
constexpr size_t WS_W2 = WS_W1 + 8388608;
constexpr size_t WS_T1 = WS_W2 + 8388608;
constexpr size_t WS_T2 = WS_T1 + 8388608;
constexpr size_t WS_UC = WS_T2 + 41943040;
constexpr size_t WS_XL = WS_UC + 41943040;
constexpr size_t WS_H  = WS_XL + 16777216;
constexpr size_t WS_Z  = WS_H + 134217728;
constexpr size_t WS_RO = WS_Z + 402653184;
constexpr size_t WS_Y  = WS_RO + 33554432;
constexpr size_t WS_GO = WS_Y + 33554432;
constexpr size_t WS_GST = WS_GO + 67108864;
constexpr size_t WS_RST = WS_GST + 134217728;
constexpr size_t WS_GDEC = WS_RST + 67108864;
constexpr size_t WS_CTL = WS_GDEC + 2097152;
constexpr size_t WS_SL1 = WS_CTL + 16384;
constexpr size_t WS_SL2 = WS_SL1 + 4194304;
constexpr size_t WS_RS1 = WS_SL2 + 4194304;
constexpr size_t WS_RS2 = WS_RS1 + 262144;
constexpr size_t WS_END = WS_RS2 + 262144;

struct Params { const float* in[25]; float* out; unsigned char* ws; };
struct S5In { const float *lam_re, *lam_im, *log_dt, *b_re, *b_im, *c_re, *c_im, *d; };

__device__ __forceinline__ float bf2f(unsigned b) { return __uint_as_float(b << 16); }
typedef __bf16 bf16v2_t __attribute__((ext_vector_type(2)));
__device__ __forceinline__ unsigned pk2(float lo, float hi) { const f32x2 v = {lo, hi}; const bf16v2_t b = __builtin_convertvector(v, bf16v2_t); return __builtin_bit_cast(unsigned, b); }
__device__ __forceinline__ unsigned f2bf(float f) { return pk2(f, f) & 0xffffu; }

__device__ __forceinline__ float sigmoidf_(float x) { return __builtin_amdgcn_rcpf(1.0f + __expf(-x)); }
__device__ __forceinline__ void sincos_turns(double turns, float& s, float& c) { turns -= rint(turns); const float t = (float)turns; s = __builtin_amdgcn_sinf(t); c = __builtin_amdgcn_cosf(t); }
__device__ __forceinline__ int ltid(int wv) { int lane; asm volatile("v_mbcnt_lo_u32_b32 %0, -1, 0\n\tv_mbcnt_hi_u32_b32 %0, -1, %0" : "=v"(lane)); return wv * 64 + lane; }
__device__ __forceinline__ int lbid() { int t = blockIdx.x; asm volatile("" : "+s"(t)); return t; }
__device__ __forceinline__ int lgdim() { int t = gridDim.x; asm volatile("" : "+s"(t)); return t; }
__device__ __forceinline__ float shx(float v, int mask, int lane) { return __int_as_float(__builtin_amdgcn_ds_bpermute((lane ^ mask) << 2, __float_as_int(v))); }
constexpr double INV2PI = 0.15915494309189533577;
__device__ __forceinline__ f32x2 gelu_pk(f32x2 v) {
    const f32x2 av = __builtin_elementwise_abs(v), d = av * 0.2316418882f + 1.0f;
    f32x2 t; t.x = __builtin_amdgcn_rcpf(d.x); t.y = __builtin_amdgcn_rcpf(d.y);
    f32x2 q = t * 0.5307027145f + (-0.7265760135f); q = q * t + 0.7107068705f; q = q * t + (-0.142248368f); q = q * t + 0.127414796f; q = q * t;
    const f32x2 s = (v * v) * (-0.72134752044f);
    f32x2 e; e.x = __builtin_amdgcn_exp2f(s.x); e.y = __builtin_amdgcn_exp2f(s.y);
    const f32x2 m = v * (q * e), r = v - m;
    f32x2 o; o.x = v.x < 0.f ? m.x : r.x; o.y = v.y < 0.f ? m.y : r.y; return o;
}

namespace pg8 {
constexpr int BM = 256, BK = 64, HALF = 128, HTB = HALF * BK * 2, STAGE_BYTES = 8 * HTB, NXCD = 8, WGM = 8;
__device__ __forceinline__ int lds_byte(int r, int c) { const int st = (r >> 4) * 2 + (c >> 5), rr = r & 15, cc = c & 31, ob = rr * 64 + cc * 2; return st * 1024 + (ob ^ (((ob >> 9) & 1) << 5)); }
__device__ __forceinline__ void stage_rc(int b, int& R, int& C) { const int st = b / 1024, sb = b % 1024, swz = sb ^ (((sb >> 9) & 1) << 5); R = (st >> 1) * 16 + swz / 64; C = (st & 1) * 32 + (swz % 64) / 2; }
__device__ __forceinline__ int perm32(int rho) { const int n = rho >> 4, i = rho & 15; return 8 * (i >> 2) + 4 * n + (i & 3); }

struct Unit { int pm, pn, bt; };

__device__ __forceinline__ void remap(int L, int nM, int nN, int& pm, int& pn) {
    const int nwg = nM * nN; int wgid = L;
    { const int q = nwg / NXCD, r = nwg % NXCD, xcd = wgid % NXCD, off = wgid / NXCD; wgid = (xcd < r ? xcd * (q + 1) : r * (q + 1) + (xcd - r) * q) + off; }
    const int nig = WGM * nN, gid = wgid / nig, fm = gid * WGM, gsz = (nM - fm) < WGM ? (nM - fm) : WGM;
    pm = fm + ((wgid % nig) % gsz); pn = (wgid % nig) / gsz;
}
struct OrderStd {
    const char* A; const char* Bt; int nM, nN, G, c; size_t tA, tB;
    __device__ __forceinline__ void init(const void* A_, int lda, const void* Bt_, int ldb, int M, int N) { A = (const char*)A_; Bt = (const char*)Bt_; nM = M / BM; nN = N / BM; G = lgdim(); c = lbid(); tA = (size_t)BM * lda * 2; tB = (size_t)BM * ldb * 2; }
    __device__ __forceinline__ bool next(int i, Unit& u) const { const long L = (long)i * G + c; if (L >= (long)nM * nN) return false; remap((int)L, nM, nN, u.pm, u.pn); u.bt = 0; return true; }
    __device__ __forceinline__ const char* a_ptr(const Unit& u) const { return A + (size_t)u.pm * tA; }
    __device__ __forceinline__ const char* b_ptr(const Unit& u) const { return Bt + (size_t)u.pn * tB; }
};
struct OrderMerge {
    const char* A; const char* Bt; int nM, G, c; size_t tA, tB;
    __device__ __forceinline__ void init(const void* A_, int lda, const void* Bt_, int ldb, int M) { A = (const char*)A_; Bt = (const char*)Bt_; nM = M / BM; G = lgdim(); c = lbid(); tA = (size_t)BM * lda * 2; tB = (size_t)BM * ldb * 2; }
    __device__ __forceinline__ bool next(int i, Unit& u) const { const int sup = i / 3, seg = i - sup * 3; const long L = (long)sup * G + c; if (L >= (long)nM * 4) return false; int j; remap((int)L, nM, 4, u.pm, j); u.pn = seg * 4 + j; u.bt = 0; return true; }
    __device__ __forceinline__ const char* a_ptr(const Unit& u) const { return A + (size_t)u.pm * tA; }
    __device__ __forceinline__ const char* b_ptr(const Unit& u) const { return Bt + (size_t)u.pn * tB; }
};
struct OrderBatch {
    const char* A; const char* Bt; int nM, nN, G, c; size_t tA, tB, gA, gB;
    __device__ __forceinline__ void init(const void* A_, int lda, size_t gA_, const void* Bt_, int ldb, size_t gB_, int nM_, int nN_) { A = (const char*)A_; Bt = (const char*)Bt_; nM = nM_; nN = nN_; G = lgdim(); c = lbid(); tA = (size_t)BM * lda * 2; tB = (size_t)BM * ldb * 2; gA = gA_; gB = gB_; }
    __device__ __forceinline__ bool next(int i, Unit& u) const {
        const long L = (long)i * G + c; const int per = nM * nN; if (L >= 16L * per) return false;
        const int x = (int)(L & 7), r = (int)(L >> 3), npx = 2 * per;
        const int g = 2 * x + r / per, t = r % per; (void)npx;
        u.bt = g; u.pm = t / nN; u.pn = t % nN; return true; }
    __device__ __forceinline__ const char* a_ptr(const Unit& u) const { return A + (size_t)u.bt * gA + (size_t)u.pm * tA; }
    __device__ __forceinline__ const char* b_ptr(const Unit& u) const { return Bt + (size_t)u.bt * gB + (size_t)u.pn * tB; }
};

template <bool ALIGN_EPI = true, bool SP2 = true, class Epi, class Sched>
__device__ __forceinline__ void gemm_phase(LAS unsigned char* lds, const Sched& S, const Epi& E, const int K, const int lda, const int ldb, const int wv) {
    int tid_ = ltid(wv);
    const int tid = tid_, wid = __builtin_amdgcn_readfirstlane(tid >> 6), lane = tid & 63, wr = wid >> 2, wc = wid & 3, fr = lane & 15, fq = lane >> 4;
    const int nt = K / BK;
    unsigned voffA[2], voffB[2];
#pragma unroll
    for (int i = 0; i < 2; ++i) { int R, C; stage_rc(tid * 16 + i * 8192, R, C); const int Rb = Epi::PERM ? ((R & ~31) + perm32(R & 31)) : R;
        voffA[i] = (unsigned)(R * lda + C) * 2u; voffB[i] = (unsigned)(Rb * ldb + C) * 2u; }
    const size_t kstep = (size_t)(BK * 2);
    const size_t hstepA = (size_t)HALF * lda * 2, hstepB = (size_t)HALF * ldb * 2;
    const unsigned ldsw = (unsigned)wid * 1024u;
    const int aoff = lds_byte(wr * 64 + fr, fq * 8), boff = lds_byte(wc * 32 + fr, fq * 8);
#define PG8_SA(b, h) (((b) * 2 + (h)) * HTB)
#define PG8_SB(b, h) ((4 + (b) * 2 + (h)) * HTB)
#define PG8_STAGE(bufoff, gbase, voff) do { _Pragma("unroll") for (int _i = 0; _i < 2; ++_i) \
        __builtin_amdgcn_global_load_lds((const unsigned*)((const char*)(gbase) + (voff)[_i]), (LAS unsigned*)(lds + (bufoff) + ldsw + _i * 8192), 16, 0, 0); } while (0)
#define PG8_LDA(dst, b, h) do { _Pragma("unroll") for (int m = 0; m < 4; ++m) _Pragma("unroll") for (int k = 0; k < 2; ++k) dst[m][k] = *(const LAS bf16x8*)(lds + PG8_SA(b, h) + aoff + m * 2048 + k * 1024); } while (0)
#define PG8_LDB(dst, b, h) do { _Pragma("unroll") for (int n = 0; n < 2; ++n) _Pragma("unroll") for (int k = 0; k < 2; ++k) dst[n][k] = *(const LAS bf16x8*)(lds + PG8_SB(b, h) + boff + n * 2048 + k * 1024); } while (0)
#define PG8_MMA(ai, bj, At, Bt) do { __builtin_amdgcn_s_setprio(1); _Pragma("unroll") for (int m = 0; m < 4; ++m) _Pragma("unroll") for (int n = 0; n < 2; ++n) _Pragma("unroll") for (int k = 0; k < 2; ++k) \
        acc[ai][bj][m][n] = __builtin_amdgcn_mfma_f32_16x16x32_bf16(Bt[n][k], At[m][k], acc[ai][bj][m][n], 0, 0, 0); __builtin_amdgcn_s_setprio(0); } while (0)
#define PG8_WAIT_V(n) asm volatile("s_waitcnt vmcnt(" #n ")" ::: "memory")
#define PG8_WAIT_L(n) asm volatile("s_waitcnt lgkmcnt(" #n ")" ::: "memory")
#define PG8_BAR __builtin_amdgcn_s_barrier()
#define PG8_SCHED __builtin_amdgcn_sched_barrier(0)
    Unit cur, nxt; int ui = 0;
    if (!S.next(0, cur)) return;
    f32x4 acc[2][2][4][2];
#pragma unroll
    for (int a = 0; a < 2; ++a)
#pragma unroll
        for (int b = 0; b < 2; ++b)
#pragma unroll
            for (int m = 0; m < 4; ++m)
#pragma unroll
                for (int n = 0; n < 2; ++n) acc[a][b][m][n] = (f32x4){0.f, 0.f, 0.f, 0.f};
    bf16x8 At[4][2], B0[2][2], B1[2][2];
    const char* cA = S.a_ptr(cur); const char* cB = S.b_ptr(cur);
    if constexpr (SP2) {
        PG8_STAGE(PG8_SB(0, 0), cB, voffB); PG8_STAGE(PG8_SB(0, 1), cB + hstepB, voffB); PG8_STAGE(PG8_SA(0, 0), cA, voffA); PG8_STAGE(PG8_SA(0, 1), cA + hstepA, voffA);
        if (wr == 1) PG8_BAR;
        PG8_WAIT_V(2); PG8_BAR;
        PG8_STAGE(PG8_SB(1, 0), cB + kstep, voffB); PG8_STAGE(PG8_SA(1, 0), cA + kstep, voffA); PG8_STAGE(PG8_SB(1, 1), cB + hstepB + kstep, voffB);
        PG8_WAIT_V(6); PG8_BAR;
    } else {
    PG8_STAGE(PG8_SB(0, 0), cB, voffB); PG8_STAGE(PG8_SA(0, 0), cA, voffA); PG8_STAGE(PG8_SB(0, 1), cB + hstepB, voffB); PG8_STAGE(PG8_SA(0, 1), cA + hstepA, voffA);
    if (wr == 1) PG8_BAR;
    PG8_WAIT_V(4); PG8_BAR;
    PG8_STAGE(PG8_SB(1, 0), cB + kstep, voffB); PG8_STAGE(PG8_SA(1, 0), cA + kstep, voffA); PG8_STAGE(PG8_SB(1, 1), cB + hstepB + kstep, voffB);
    PG8_WAIT_V(6); PG8_BAR;
    }
    for (;;) {
        const bool has_next = S.next(ui + 1, nxt);
        float rsv[8];
        if constexpr (Epi::NEEDS_RS) { const int l3 = ltid(wv) & 15; const float* rp = E.rs + cur.pm * BM + wr * 64 + l3;
#pragma unroll
            for (int q8 = 0; q8 < 8; ++q8) rsv[q8] = rp[(q8 >> 2) * HALF + (q8 & 3) * 16]; }
        const char* nA = has_next ? S.a_ptr(nxt) : cA; const char* nB = has_next ? S.b_ptr(nxt) : cB;
        for (int t = 0; t < nt; t += 2) {
            const bool last = (t == nt - 2);
            const char* a1 = cA + (size_t)(t + 1) * kstep;
            const char* a2 = last ? nA : cA + (size_t)(t + 2) * kstep; const char* b2 = last ? nB : cB + (size_t)(t + 2) * kstep;
            const char* a3 = a2 + kstep; const char* b3 = b2 + kstep;
            if constexpr (SP2) {
            PG8_LDB(B0, 0, 0); PG8_LDB(B1, 0, 1); PG8_SCHED; PG8_LDA(At, 0, 0); PG8_STAGE(PG8_SA(1, 1), a1 + hstepA, voffA);
            PG8_WAIT_V(8); PG8_WAIT_L(0); PG8_BAR; PG8_MMA(0, 0, At, B0); PG8_MMA(0, 1, At, B1); PG8_BAR; PG8_SCHED;
            PG8_LDA(At, 0, 1); PG8_STAGE(PG8_SB(0, 0), b2, voffB); PG8_STAGE(PG8_SB(0, 1), b2 + hstepB, voffB); PG8_STAGE(PG8_SA(0, 0), a2, voffA);
            PG8_WAIT_V(8); PG8_WAIT_L(0); PG8_BAR; PG8_MMA(1, 0, At, B0); PG8_MMA(1, 1, At, B1); PG8_BAR; PG8_SCHED;
            PG8_LDB(B0, 1, 0); PG8_LDB(B1, 1, 1); PG8_SCHED; PG8_LDA(At, 1, 0); PG8_STAGE(PG8_SA(0, 1), a2 + hstepA, voffA);
            PG8_WAIT_V(8); PG8_WAIT_L(0); PG8_BAR; PG8_MMA(0, 0, At, B0); PG8_MMA(0, 1, At, B1); PG8_BAR; PG8_SCHED;
            PG8_LDA(At, 1, 1); PG8_STAGE(PG8_SB(1, 0), b3, voffB); PG8_STAGE(PG8_SB(1, 1), b3 + hstepB, voffB); PG8_STAGE(PG8_SA(1, 0), a3, voffA);
            PG8_WAIT_V(8); PG8_WAIT_L(0); PG8_BAR; PG8_MMA(1, 0, At, B0); PG8_MMA(1, 1, At, B1); PG8_BAR; PG8_SCHED;
            } else {
            PG8_LDB(B0, 0, 0); PG8_SCHED; PG8_LDA(At, 0, 0); PG8_STAGE(PG8_SA(1, 1), a1 + hstepA, voffA);
            PG8_WAIT_L(8); PG8_BAR; PG8_WAIT_L(0); PG8_MMA(0, 0, At, B0); PG8_BAR; PG8_SCHED;
            PG8_LDB(B1, 0, 1); PG8_STAGE(PG8_SB(0, 0), b2, voffB);
            PG8_BAR; PG8_WAIT_L(0); PG8_MMA(0, 1, At, B1); PG8_BAR;
            PG8_LDA(At, 0, 1); PG8_STAGE(PG8_SA(0, 0), a2, voffA);
            PG8_BAR; PG8_WAIT_L(0); PG8_MMA(1, 0, At, B0); PG8_BAR; PG8_SCHED;
            PG8_STAGE(PG8_SB(0, 1), b2 + hstepB, voffB);
            PG8_WAIT_V(6); PG8_BAR; PG8_MMA(1, 1, At, B1); PG8_BAR;
            PG8_LDB(B0, 1, 0); PG8_SCHED; PG8_LDA(At, 1, 0); PG8_STAGE(PG8_SA(0, 1), a2 + hstepA, voffA);
            PG8_WAIT_L(8); PG8_BAR; PG8_WAIT_L(0); PG8_MMA(0, 0, At, B0); PG8_BAR; PG8_SCHED;
            PG8_LDB(B1, 1, 1); PG8_STAGE(PG8_SB(1, 0), b3, voffB);
            PG8_BAR; PG8_WAIT_L(0); PG8_MMA(0, 1, At, B1); PG8_BAR;
            PG8_LDA(At, 1, 1); PG8_STAGE(PG8_SA(1, 0), a3, voffA);
            PG8_BAR; PG8_WAIT_L(0); PG8_MMA(1, 0, At, B0); PG8_BAR; PG8_SCHED;
            PG8_STAGE(PG8_SB(1, 1), b3 + hstepB, voffB);
            PG8_WAIT_V(6); PG8_BAR; PG8_MMA(1, 1, At, B1); PG8_BAR;
            }
        }
        if constexpr (ALIGN_EPI) { if (wr == 0) PG8_BAR; }
        { const int l2 = ltid(wv) & 63; E(acc, cur, wr, wc, l2 & 15, l2 >> 4, rsv); }
        if (!has_next) break;
#pragma unroll
        for (int a = 0; a < 2; ++a)
#pragma unroll
            for (int b = 0; b < 2; ++b)
#pragma unroll
                for (int m = 0; m < 4; ++m)
#pragma unroll
                    for (int n = 0; n < 2; ++n) acc[a][b][m][n] = (f32x4){0.f, 0.f, 0.f, 0.f};
        cur = nxt; cA = nA; cB = nB; ++ui;
        if constexpr (ALIGN_EPI) { if (wr == 1) PG8_BAR; }
    }
    PG8_WAIT_V(0);
    if constexpr (!ALIGN_EPI) { if (wr == 0) PG8_BAR; }
    PG8_BAR;
#undef PG8_SA
#undef PG8_SB
#undef PG8_STAGE
#undef PG8_LDA
#undef PG8_LDB
#undef PG8_MMA
#undef PG8_WAIT_V
#undef PG8_WAIT_L
#undef PG8_BAR
#undef PG8_SCHED
}

typedef const f32x4 (&AccRef)[2][2][4][2];

struct EpiZ {
    static constexpr bool PERM = true; static constexpr bool NEEDS_RS = true; bf16_t* z; bf16_t* uc; const float* rs;
    __device__ __forceinline__ void operator()(AccRef acc, const Unit& u, int wr, int wc, int fr, int fq, const float (&rsv)[8]) const {
        const int row0 = u.pm * BM + wr * 64 + fr;
#pragma unroll
        for (int ai = 0; ai < 2; ++ai)
#pragma unroll
            for (int m = 0; m < 4; ++m) { const int r = row0 + ai * HALF + m * 16;
#pragma unroll
                for (int bj = 0; bj < 2; ++bj) { const f32x4 v0 = acc[ai][bj][m][0] * rsv[ai * 4 + m], v1 = acc[ai][bj][m][1] * rsv[ai * 4 + m];
                    u32x4 w; w.x = pk2(v0[0], v0[1]); w.y = pk2(v0[2], v0[3]); w.z = pk2(v1[0], v1[1]); w.w = pk2(v1[2], v1[3]);
                    const int c0 = u.pn * BM + bj * HALF + wc * 32 + 8 * fq;
                    if (u.pn == 4) { const int cc = c0 - C_SU, g = cc >> 4, c8 = cc & 15, b = r >> 12, t = r & 4095;
                        *(u32x4*)(uc + ((size_t)(g * 1024 + b * 64 + (t >> 6)) * 1280 + (t & 63) * 16 + c8)) = w; }
                    else { const int tb = r >> 6, i = r & 63; size_t off;
                        if (c0 < 1024) off = ZR_OFF + ((size_t)(tb * 4 + ((c0 >> 6) & 3)) * 64 + i) * 256 + (c0 >> 8) * 64 + (c0 & 63);
                        else if (c0 < C_GV) off = ZG_OFF + ((size_t)(tb * 4 + (((c0 - C_GQ) >> 6) & 3)) * 64 + i) * 384 + ((c0 - C_GQ) >> 8) * 64 + (c0 & 63);
                        else if (c0 < C_LR) { const int cc = c0 - C_GV, sec = cc >> 9, hh = (cc >> 7) & 3; off = ZG_OFF + ((size_t)(tb * 4 + hh) * 64 + i) * 384 + 128 + sec * 128 + (cc & 127); }
                        else off = ZL_OFF + (size_t)r * 16 + (c0 - C_LR);
                        if (c0 < C_LR + 16) *(u32x4*)(z + off) = w; } } }
    }
};
struct EpiXloc {
    static constexpr bool PERM = false; static constexpr bool NEEDS_RS = false; float* X;
    __device__ __forceinline__ void operator()(AccRef acc, const Unit& u, int wr, int wc, int fr, int fq, const float (&rsv)[8]) const {
        float* base = X + (size_t)u.bt * 1024 * 256; const int row0 = u.pm * BM + wr * 64 + fr, col0 = wc * 32 + 4 * fq;
#pragma unroll
        for (int ai = 0; ai < 2; ++ai)
#pragma unroll
            for (int m = 0; m < 4; ++m) { float* rowp = base + (size_t)(row0 + ai * HALF + m * 16) * 256 + col0;
#pragma unroll
                for (int bj = 0; bj < 2; ++bj)
#pragma unroll
                    for (int n = 0; n < 2; ++n) *(f32x4*)(rowp + bj * HALF + n * 16) = acc[ai][bj][m][n]; }
    }
};
struct EpiS5Y {
    static constexpr bool PERM = true; static constexpr bool NEEDS_RS = false; bf16_t* Y;
    __device__ __forceinline__ void operator()(AccRef acc, const Unit& u, int wr, int wc, int fr, int fq, const float (&rsv)[8]) const {
        const int row0 = u.pm * BM + wr * 64 + fr;
#pragma unroll
        for (int ai = 0; ai < 2; ++ai)
#pragma unroll
            for (int m = 0; m < 4; ++m) { const int r = row0 + ai * HALF + m * 16;
                const int b = r >> 6, n = r & 63;
#pragma unroll
                for (int bj = 0; bj < 2; ++bj) { const f32x4 v0 = acc[ai][bj][m][0], v1 = acc[ai][bj][m][1];
                    const f32x2 a = gelu_pk((f32x2){v0[0], v0[1]}), bb = gelu_pk((f32x2){v0[2], v0[3]}), c = gelu_pk((f32x2){v1[0], v1[1]}), d = gelu_pk((f32x2){v1[2], v1[3]});
                    u32x4 w; w.x = pk2(a.x, a.y); w.y = pk2(bb.x, bb.y); w.z = pk2(c.x, c.y); w.w = pk2(d.x, d.y);
                    const int c0 = u.pn * BM + bj * HALF + wc * 32 + 8 * fq, t = c0 >> 4, c8 = c0 & 15;
                    *(u32x4*)(Y + (size_t)(b * SEQ + n * 64 + t) * 256 + u.bt * 16 + c8) = w; } }
    }
};
template <int ACT  > struct EpiBf16 {
    static constexpr bool PERM = true; static constexpr bool NEEDS_RS = false; bf16_t* O; int ldc;
    __device__ __forceinline__ void operator()(AccRef acc, const Unit& u, int wr, int wc, int fr, int fq, const float (&rsv)[8]) const {
        const int row0 = u.pm * BM + wr * 64 + fr, col0 = u.pn * BM + wc * 32 + 8 * fq;
#pragma unroll
        for (int ai = 0; ai < 2; ++ai)
#pragma unroll
            for (int m = 0; m < 4; ++m) { bf16_t* rowp = O + (size_t)(row0 + ai * HALF + m * 16) * ldc + col0;
#pragma unroll
                for (int bj = 0; bj < 2; ++bj) { f32x4 v0 = acc[ai][bj][m][0], v1 = acc[ai][bj][m][1];
                    if (ACT == 1) {
#pragma unroll
                        for (int j = 0; j < 4; ++j) { const float a = __builtin_amdgcn_fmed3f(v0[j], 0.f, 3.0e38f), b = __builtin_amdgcn_fmed3f(v1[j], 0.f, 3.0e38f); v0[j] = a * a; v1[j] = b * b; } }
                    u32x4 w; w.x = pk2(v0[0], v0[1]); w.y = pk2(v0[2], v0[3]); w.z = pk2(v1[0], v1[1]); w.w = pk2(v1[2], v1[3]);
                    *(u32x4*)(rowp + bj * HALF) = w; } }
    }
};
struct EpiGLU {
    static constexpr bool PERM = true; static constexpr bool NEEDS_RS = false; bf16_t* O;
    __device__ __forceinline__ void operator()(AccRef acc, const Unit& u, int wr, int wc, int fr, int fq, const float (&rsv)[8]) const {
        const int row0 = u.pm * BM + wr * 64 + fr, col0 = u.pn * HALF + wc * 32 + 8 * fq;
#pragma unroll
        for (int ai = 0; ai < 2; ++ai)
#pragma unroll
            for (int m = 0; m < 4; ++m) { bf16_t* rowp = O + (size_t)(row0 + ai * HALF + m * 16) * DM + col0;
                f32x4 v0 = acc[ai][0][m][0], v1 = acc[ai][0][m][1]; const f32x4 g0 = acc[ai][1][m][0], g1 = acc[ai][1][m][1];
#pragma unroll
                for (int j = 0; j < 4; ++j) { v0[j] *= sigmoidf_(g0[j]); v1[j] *= sigmoidf_(g1[j]); }
                u32x4 w; w.x = pk2(v0[0], v0[1]); w.y = pk2(v0[2], v0[3]); w.z = pk2(v1[0], v1[1]); w.w = pk2(v1[2], v1[3]);
                *(u32x4*)rowp = w; }
    }
};
struct EpiMerge {
    static constexpr bool PERM = true; static constexpr bool NEEDS_RS = true; const bf16_t* br; bf16_t* mg; const float* bias; const float* rs;
    __device__ __forceinline__ void operator()(AccRef acc, const Unit& u, int wr, int wc, int fr, int fq, const float (&rsv)[8]) const {
        const int seg = u.pn >> 2, j = u.pn & 3;
        const int row0 = u.pm * BM + wr * 64 + fr, ch0 = j * BM + wc * 32 + 8 * fq;
        const bf16_t* brs = br + (size_t)seg * NTOK * DM;
        f32x4 bv[2][2];
#pragma unroll
        for (int bj = 0; bj < 2; ++bj)
#pragma unroll
            for (int n = 0; n < 2; ++n) bv[bj][n] = *(const f32x4*)(bias + seg * DM + ch0 + bj * HALF + 4 * n);
#pragma unroll
        for (int ai = 0; ai < 2; ++ai)
#pragma unroll
            for (int m = 0; m < 4; ++m) { const size_t ro = (size_t)(row0 + ai * HALF + m * 16) * DM + ch0;
#pragma unroll
                for (int bj = 0; bj < 2; ++bj) { const f32x4 a0 = acc[ai][bj][m][0] * rsv[ai * 4 + m] + bv[bj][0], a1 = acc[ai][bj][m][1] * rsv[ai * 4 + m] + bv[bj][1];
                    const u32x4 bw = *(const u32x4*)(brs + ro + bj * HALF);
                    float r[8];
                    r[0] = bf2f(bw.x & 0xffffu) * sigmoidf_(a0[0]); r[1] = bf2f(bw.x >> 16) * sigmoidf_(a0[1]); r[2] = bf2f(bw.y & 0xffffu) * sigmoidf_(a0[2]); r[3] = bf2f(bw.y >> 16) * sigmoidf_(a0[3]);
                    r[4] = bf2f(bw.z & 0xffffu) * sigmoidf_(a1[0]); r[5] = bf2f(bw.z >> 16) * sigmoidf_(a1[1]); r[6] = bf2f(bw.w & 0xffffu) * sigmoidf_(a1[2]); r[7] = bf2f(bw.w >> 16) * sigmoidf_(a1[3]);
                    if (seg != 0) { const u32x4 mw = *(const u32x4*)(mg + ro + bj * HALF);
                        r[0] += bf2f(mw.x & 0xffffu); r[1] += bf2f(mw.x >> 16); r[2] += bf2f(mw.y & 0xffffu); r[3] += bf2f(mw.y >> 16);
                        r[4] += bf2f(mw.z & 0xffffu); r[5] += bf2f(mw.z >> 16); r[6] += bf2f(mw.w & 0xffffu); r[7] += bf2f(mw.w >> 16); }
                    u32x4 w; w.x = pk2(r[0], r[1]); w.y = pk2(r[2], r[3]); w.z = pk2(r[4], r[5]); w.w = pk2(r[6], r[7]);
                    *(u32x4*)(mg + ro + bj * HALF) = w; } }
    }
};
template <bool SCALE  > struct EpiResNorm {
    static constexpr bool PERM = true; static constexpr bool NEEDS_RS = SCALE; static constexpr int PMODE = 1; const float* Xin; float* X; bf16_t* XG; const float* g; float* slots; const float* rs;
    __device__ __forceinline__ void operator()(AccRef acc, const Unit& u, int wr, int wc, int fr, int fq, const float (&rsv)[8]) const {
        const int row0 = u.pm * BM + wr * 64 + fr, col0 = u.pn * BM + wc * 32 + 8 * fq, lane = fq * 16 + fr;
        f32x4 gv[2][2];
#pragma unroll
        for (int bj = 0; bj < 2; ++bj)
#pragma unroll
            for (int n = 0; n < 2; ++n) gv[bj][n] = XG ? *(const f32x4*)(g + col0 + bj * HALF + n * 4) : (f32x4){0.f, 0.f, 0.f, 0.f};
#pragma unroll
        for (int ai = 0; ai < 2; ++ai)
#pragma unroll
            for (int m = 0; m < 4; ++m) { const int r = row0 + ai * HALF + m * 16; const size_t ro = (size_t)r * DM + col0; float ss = 0.f; const float rq = SCALE ? rsv[ai * 4 + m] * rsv[ai * 4 + m] : 1.0f;
#pragma unroll
                for (int bj = 0; bj < 2; ++bj) { const f32x4* qi = (const f32x4*)(Xin + ro + bj * HALF); f32x4* qo = (f32x4*)(X + ro + bj * HALF);
                    const f32x4 v0 = qi[0] + acc[ai][bj][m][0] * rq, v1 = qi[1] + acc[ai][bj][m][1] * rq; qo[0] = v0; qo[1] = v1;
                    ss += (v0[0] * v0[0] + v0[1] * v0[1]) + (v0[2] * v0[2] + v0[3] * v0[3]) + (v1[0] * v1[0] + v1[1] * v1[1]) + (v1[2] * v1[2] + v1[3] * v1[3]);
                    if (XG) { const f32x4 y0 = v0 * gv[bj][0], y1 = v1 * gv[bj][1]; u32x4 w; w.x = pk2(y0[0], y0[1]); w.y = pk2(y0[2], y0[3]); w.z = pk2(y1[0], y1[1]); w.w = pk2(y1[2], y1[3]);
                        *(u32x4*)(XG + ro + bj * HALF) = w; } }
                ss += shx(ss, 16, lane); ss += shx(ss, 32, lane);
                if (fq == 0) slots[(size_t)r * 16 + u.pn * 4 + wc] = ss; }
    }
};
}

__device__ __forceinline__ float wave_sum(float v, int lane) {
#pragma unroll
    for (int o = 1; o < 64; o <<= 1) v += shx(v, o, lane);
    return v;
}
__device__ __forceinline__ void rmsnorm_phase(const float* xin, float* xcopy, const float* g, bf16_t* h, const int wv) {
    const int tid = ltid(wv), lane = tid & 63, wave = tid >> 6, step = lgdim() * 8;
    f32x4 gv[4];
#pragma unroll
    for (int i = 0; i < 4; ++i) gv[i] = *(const f32x4*)(g + i * 256 + lane * 4);
    int row = lbid() * 8 + wave; f32x4 v[4], nv[4];
    if (row < NTOK) {
#pragma unroll
        for (int i = 0; i < 4; ++i) v[i] = *(const f32x4*)(xin + (size_t)row * DM + i * 256 + lane * 4); }
    for (; row < NTOK; row += step) {
        if (row + step < NTOK) {
#pragma unroll
            for (int i = 0; i < 4; ++i) nv[i] = *(const f32x4*)(xin + (size_t)(row + step) * DM + i * 256 + lane * 4); }
        float s = 0.f;
#pragma unroll
        for (int i = 0; i < 4; ++i) s += v[i][0] * v[i][0] + v[i][1] * v[i][1] + v[i][2] * v[i][2] + v[i][3] * v[i][3];
        s = wave_sum(s, lane); const float rs = __builtin_amdgcn_rsqf(s * (1.0f / DM) + EPS);
#pragma unroll
        for (int i = 0; i < 4; ++i) { u32x2 w; w.x = pk2(v[i][0] * rs * gv[i][0], v[i][1] * rs * gv[i][1]); w.y = pk2(v[i][2] * rs * gv[i][2], v[i][3] * rs * gv[i][3]);
            *(u32x2*)(h + (size_t)row * DM + i * 256 + lane * 4) = w;
            if (xcopy) *(f32x4*)(xcopy + (size_t)row * DM + i * 256 + lane * 4) = v[i]; }
#pragma unroll
        for (int i = 0; i < 4; ++i) v[i] = nv[i];
    }
}
__device__ __forceinline__ float slot_rs(const float* slots, int r) { const f32x4* p = (const f32x4*)(slots + (size_t)r * 16); const f32x4 a = p[0], b = p[1], c = p[2], d = p[3];
    const float s = ((a[0] + a[1]) + (a[2] + a[3])) + ((b[0] + b[1]) + (b[2] + b[3])) + ((c[0] + c[1]) + (c[2] + c[3])) + ((d[0] + d[1]) + (d[2] + d[3]));
    return __builtin_amdgcn_rsqf(s * (1.0f / DM) + EPS); }
__device__ __forceinline__ void rs_phase(const float* slots, float* rs, const int wv) { for (int r = lbid() * 512 + ltid(wv); r < NTOK; r += lgdim() * 512) rs[r] = slot_rs(slots, r); }
__device__ __forceinline__ void prep0_phase(const float* xin, const float* g, bf16_t* xg, float* rs, const int wv) {
    const int tid = ltid(wv), lane = tid & 63, wave = tid >> 6;
    f32x4 gv[4];
#pragma unroll
    for (int i = 0; i < 4; ++i) gv[i] = *(const f32x4*)(g + i * 256 + lane * 4);
    for (int row = lbid() * 8 + wave; row < NTOK; row += lgdim() * 8) {
        const float* xr = xin + (size_t)row * DM; f32x4 v[4]; float s = 0.f;
#pragma unroll
        for (int i = 0; i < 4; ++i) { v[i] = *(const f32x4*)(xr + i * 256 + lane * 4); s += v[i][0] * v[i][0] + v[i][1] * v[i][1] + v[i][2] * v[i][2] + v[i][3] * v[i][3]; }
        s = wave_sum(s, lane);
        if (lane == 0) rs[row] = __builtin_amdgcn_rsqf(s * (1.0f / DM) + EPS);
#pragma unroll
        for (int i = 0; i < 4; ++i) { u32x2 w; w.x = pk2(v[i][0] * gv[i][0], v[i][1] * gv[i][1]); w.y = pk2(v[i][2] * gv[i][2], v[i][3] * gv[i][3]);
            *(u32x2*)(xg + (size_t)row * DM + i * 256 + lane * 4) = w; }
    }
}
__device__ __forceinline__ void final_norm_phase(float* x, const float* g, const float* slots, const int wv) {
    const int tid = ltid(wv), lane = tid & 63, wave = tid >> 6;
    f32x4 gv[4];
#pragma unroll
    for (int i = 0; i < 4; ++i) gv[i] = *(const f32x4*)(g + i * 256 + lane * 4);
    for (int row = lbid() * 8 + wave; row < NTOK; row += lgdim() * 8) {
        float* xr = x + (size_t)row * DM; const float rs = slot_rs(slots, row);
#pragma unroll
        for (int i = 0; i < 4; ++i) { const f32x4 v = *(const f32x4*)(xr + i * 256 + lane * 4); *(f32x4*)(xr + i * 256 + lane * 4) = v * rs * gv[i]; }
    }
}

template <class Map>
__device__ __forceinline__ void conv_issue(const float* src, int Nsrc, int ntn, int t, int tid, Map map, float (&r)[8]) {
    const int tn = t % ntn, tk = t / ntn;
#pragma unroll
    for (int it = 0; it < 8; ++it) { const int idx = it * 512 + tid, kk = idx >> 6, nn = idx & 63; const int col = map(tn * 64 + nn);
        r[it] = col >= 0 ? src[(size_t)(tk * 64 + kk) * Nsrc + col] : 0.f; }
}
template <class Map>
__device__ __forceinline__ void conv_T(LAS unsigned char* lds, const float* src, int K, int Nsrc, bf16_t* dst, int Ndst, Map map, const int wv) {
    LAS float* tile = (LAS float*)lds;
    const int tid = ltid(wv), ntn = Ndst / 64, ntiles = ntn * (K / 64), G = lgdim();
    float cur[8], nx1[8], nx2[8];
    int t = lbid();
    if (t < ntiles) conv_issue(src, Nsrc, ntn, t, tid, map, cur);
    if (t + G < ntiles) conv_issue(src, Nsrc, ntn, t + G, tid, map, nx1);
    for (; t < ntiles; t += G) {
        if (t + 2 * G < ntiles) conv_issue(src, Nsrc, ntn, t + 2 * G, tid, map, nx2);
        const int tn = t % ntn, tk = t / ntn;
#pragma unroll
        for (int it = 0; it < 8; ++it) { const int idx = it * 512 + tid, kk = idx >> 6, nn = idx & 63; tile[nn * 65 + kk] = cur[it]; }
        asm volatile("s_waitcnt lgkmcnt(0)\n\ts_barrier" ::: "memory");
        { const int nn = tid >> 3, sg = tid & 7; LAS const float* tp = tile + nn * 65 + sg * 8;
          u32x4 w; w.x = pk2(tp[0], tp[1]); w.y = pk2(tp[2], tp[3]); w.z = pk2(tp[4], tp[5]); w.w = pk2(tp[6], tp[7]);
          *(u32x4*)(dst + (size_t)(tn * 64 + nn) * K + tk * 64 + sg * 8) = w; }
        asm volatile("s_waitcnt lgkmcnt(0)\n\ts_barrier" ::: "memory");
#pragma unroll
        for (int it = 0; it < 8; ++it) { cur[it] = nx1[it]; nx1[it] = nx2[it]; }
    }
}
struct MapId { __device__ __forceinline__ int operator()(int n) const { return n; } };
struct MapZ { __device__ __forceinline__ int operator()(int n) const { return n < 2304 ? n : (n < 2816 ? n + 16 : (n < 2832 ? n - 512 : -1)); } };
struct MapGLU { __device__ __forceinline__ int operator()(int n) const { const int pn = n >> 8, bj = (n >> 7) & 1, i = n & 127; return bj * 1024 + pn * 128 + i; } };

__device__ __forceinline__ void s5_prep(LAS unsigned char* lds, const S5In p, int l, int unit, bf16_t* T1t, bf16_t* T2t, const int wv) {
    const int tid = ltid(wv), g = unit >> 4, c = unit & 15;
    LAS f32x2* Lpow = (LAS f32x2*)lds;
    LAS f32x2* Bb = (LAS f32x2*)(lds + 66560);
    LAS f32x2* Wm = (LAS f32x2*)(lds + 66560 + 16384);
    LAS float* Kt = (LAS float*)(lds + 66560 + 32768);
    const float* lam_re = p.lam_re + (size_t)l * 2048; const float* lam_im = p.lam_im + (size_t)l * 2048; const float* log_dt = p.log_dt + (size_t)l * 32;
    const float* b_re = p.b_re + (size_t)l * 32768; const float* b_im = p.b_im + (size_t)l * 32768;
    const float* c_re = p.c_re + (size_t)l * 32768; const float* c_im = p.c_im + (size_t)l * 32768;
    {
        const int dp = tid >> 2, dir = dp >> 6, pp = dp & 63, q4 = tid & 3;
        const float lr = lam_re[(dir * 16 + g) * 64 + pp], li = lam_im[(dir * 16 + g) * 64 + pp], dt = __expf(log_dt[dir * 16 + g]);
        for (int tau = q4; tau <= 64; tau += 4) { const float mag = __expf(lr * dt * (float)tau); float s, cs; sincos_turns((double)li * (double)dt * (double)tau * INV2PI, s, cs);
            Lpow[(dir * 64 + pp) * 65 + tau] = (f32x2){mag * cs, mag * s}; }
        const float mag1 = __expf(lr * dt); float s1, c1; sincos_turns((double)li * (double)dt * INV2PI, s1, c1);
        const float nr = mag1 * c1 - 1.0f, ni = mag1 * s1, den = 1.0f / (lr * lr + li * li);
        const float rr = (nr * lr + ni * li) * den, ri = (ni * lr - nr * li) * den;
#pragma unroll
        for (int e = 0; e < 4; ++e) { const int cp = q4 * 4 + e; const float br = b_re[((dir * 16 + g) * 64 + pp) * 16 + cp], bi = b_im[((dir * 16 + g) * 64 + pp) * 16 + cp];
            Bb[(dir * 64 + pp) * 16 + cp] = (f32x2){rr * br - ri * bi, rr * bi + ri * br}; }
    }
    __syncthreads();
#pragma unroll
    for (int k = 0; k < 4; ++k) { const int idx = tid + 512 * k, dir = idx >> 10, pp = (idx >> 4) & 63;
        const float cr = c_re[((dir * 16 + g) * 16 + c) * 64 + pp], ci = c_im[((dir * 16 + g) * 16 + c) * 64 + pp]; const f32x2 b = Bb[idx];
        Wm[idx] = (f32x2){cr * b.x - ci * b.y, cr * b.y + ci * b.x}; }
    __syncthreads();
#pragma unroll
    for (int k = 0; k < 4; ++k) { const int idx = tid + 512 * k, dir = idx >> 10, tau = (idx >> 4) & 63, cp = idx & 15; float s = 0.f;
        for (int pp = 0; pp < 64; ++pp) { const f32x2 w = Wm[(dir * 64 + pp) * 16 + cp], L = Lpow[(dir * 64 + pp) * 65 + tau]; s += w.x * L.x - w.y * L.y; }
        Kt[idx] = s; }
    __syncthreads();
    const float Dv = p.d[l * 256 + g * 16 + c];
    for (int k = 0; k < 20; ++k) { const int seg = tid + 512 * k, t = seg / 160, sk = seg - t * 160; float v[8];
        if (sk < 128) { const int s = sk >> 1, c0 = (sk & 1) * 8;
#pragma unroll
            for (int e = 0; e < 8; ++e) { const int cp = c0 + e; float a = 0.f; if (t >= s) a += Kt[(t - s) * 16 + cp]; if (s >= t) a += Kt[1024 + (s - t) * 16 + cp]; if (s == t && cp == c) a += Dv; v[e] = a; } }
        else { const int kk = (sk - 128) * 8, which = kk >> 6, p0 = kk & 63, dir = which >> 1, im = which & 1, tau = dir == 0 ? t + 1 : 64 - t;
#pragma unroll
            for (int e = 0; e < 8; ++e) { const int pp = p0 + e; const float cr = c_re[((dir * 16 + g) * 16 + c) * 64 + pp], ci = c_im[((dir * 16 + g) * 16 + c) * 64 + pp]; const f32x2 L = Lpow[(dir * 64 + pp) * 65 + tau];
                v[e] = im ? -(cr * L.y + ci * L.x) : (cr * L.x - ci * L.y); } }
        u32x4 w; w.x = pk2(v[0], v[1]); w.y = pk2(v[2], v[3]); w.z = pk2(v[4], v[5]); w.w = pk2(v[6], v[7]);
        *(u32x4*)(T2t + ((size_t)g * 1024 + t * 16 + c) * 1280 + sk * 8) = w; }
#pragma unroll
    for (int k = 0; k < 4; ++k) { const int seg = tid + 512 * k, rr = seg >> 7, sk = seg & 127, dir = rr >> 3, ri = (rr >> 2) & 1, pp = 4 * c + (rr & 3), s = sk >> 1, c0 = (sk & 1) * 8;
        const f32x2 L = Lpow[(dir * 64 + pp) * 65 + (dir == 0 ? 63 - s : s)]; float v[8];
#pragma unroll
        for (int e = 0; e < 8; ++e) { const f32x2 b = Bb[(dir * 64 + pp) * 16 + c0 + e]; v[e] = ri ? (L.x * b.y + L.y * b.x) : (L.x * b.x - L.y * b.y); }
        u32x4 w; w.x = pk2(v[0], v[1]); w.y = pk2(v[2], v[3]); w.z = pk2(v[4], v[5]); w.w = pk2(v[6], v[7]);
        *(u32x4*)(T1t + ((size_t)g * 256 + dir * 128 + ri * 64 + pp) * 1024 + sk * 8) = w; }
    __syncthreads();
}
constexpr int L_BF = 0, L_BB = 16640, L_QIN = 33280, L_KIN = 42496, L_P = 51712, L_VT = 60928, L_ST = 79360, L_LR = 97792  , L_WG = 102912  ,
              L_BG = 113152  , L_TOT = 113664, L_NG = 117760  ;
constexpr int GS = 40;
constexpr int RS = 72;
template <int DV, bool GATED> struct Bla {
    const bf16_t* z; const bf16_t* zl; const float* wg; const float* bg; bf16_t* st; float* dec; const float* ng; bf16_t* out; int ldo;
};
__device__ __forceinline__ void lds_barrier() { asm volatile("s_waitcnt lgkmcnt(0)\n\ts_barrier" ::: "memory"); }
__device__ __forceinline__ bf16x8 frag(LAS const bf16_t* base, int row0, int kb, int lane) { return *(LAS const bf16x8*)(base + (row0 + (lane & 15)) * RS + kb * 32 + (lane >> 4) * 8); }
__device__ __forceinline__ void unpack4(u32x2 w, float* o) { o[0] = bf2f(w.x & 0xffffu); o[1] = bf2f(w.x >> 16); o[2] = bf2f(w.y & 0xffffu); o[3] = bf2f(w.y >> 16); }

template <int DV, bool GATED, bool S2> struct BlaRegs { u32x2 k0, k1, q0, q1; u32x4 lrf; u32x4 v[DV / 64]; u32x4 st[2][DV / 64]; u32x4 og[DV / 64]; };
template <int DV, bool GATED, bool S2>
__device__ __forceinline__ void bla_issue(const Bla<DV, GATED>& P, int unit, int tid, BlaRegs<DV, GATED, S2>& R) {
    const int b = unit >> 8, n = (unit >> 2) & 63, h = unit & 3, j = tid >> 3, sg = tid & 7; const int tok0 = b * SEQ + n * 64;
    constexpr int ROW = 128 + 2 * DV;
    const bf16_t* zr = P.z + ((size_t)((b * 64 + n) * 4 + h) * 64 + j) * ROW;
    R.k0 = *(const u32x2*)(zr + 64 + sg * 4); R.k1 = *(const u32x2*)(zr + 64 + 32 + sg * 4);
    if (S2) { R.q0 = *(const u32x2*)(zr + sg * 4); R.q1 = *(const u32x2*)(zr + 32 + sg * 4); }
    constexpr int NV = DV / 8;
#pragma unroll
    for (int q = 0; q < NV / 8; ++q) R.v[q] = *(const u32x4*)(zr + 128 + sg * NV + q * 8);
    if (GATED) { const int lane = tid & 63, jt = (tid >> 6) & 3;
        R.lrf = (lane < 32) ? *(const u32x4*)(P.zl + (size_t)(tok0 + jt * 16 + (lane & 15)) * 16 + (lane >> 4) * 8) : (u32x4){0u, 0u, 0u, 0u}; }
    if (S2) {
#pragma unroll
        for (int dir = 0; dir < 2; ++dir) { const bf16_t* stb = P.st + ((size_t)((b * 4 + h) * 2 + dir) * 64 + n) * (DV * 64);
#pragma unroll
            for (int q = 0; q < DV / 64; ++q) { const int sgi = tid + 512 * q, e = sgi >> 3, d8 = (sgi & 7) * 8; R.st[dir][q] = *(const u32x4*)(stb + e * 64 + d8); } }
#pragma unroll
        for (int q = 0; q < NV / 8; ++q) R.og[q] = *(const u32x4*)(zr + 128 + DV + sg * NV + q * 8);
    }
}
template <int DV, bool GATED>
__device__ __forceinline__ void bla_head_consts(LAS unsigned char* lds, const Bla<DV, GATED>& P, int h, int tid) {
    LAS bf16_t* wgt = (LAS bf16_t*)(lds + L_WG); LAS bf16_t* lra = (LAS bf16_t*)(lds + L_LR); LAS float* bgs = (LAS float*)(lds + L_BG); LAS float* ngs = (LAS float*)(lds + L_NG);
    if (GATED) {
#pragma unroll
        for (int k = 0; k < 4; ++k) { const int idx = tid + 512 * k, dir = idx >> 10, r = (idx >> 6) & 15, d = idx & 63; wgt[(dir * 64 + d) * GS + r] = (bf16_t)f2bf(P.wg[(dir * 16 + r) * 256 + h * 64 + d]); }
#pragma unroll
        for (int k = 0; k < 4; ++k) { const int idx = tid + 512 * k, c = idx >> 4, r = 16 + (idx & 15); wgt[c * GS + r] = 0; }
        for (int idx = tid; idx < 1024; idx += 512) lra[(idx >> 4) * GS + 16 + (idx & 15)] = 0;
        if (tid < 128) bgs[tid] = P.bg[(tid >> 6) * 256 + h * 64 + (tid & 63)];
    }
    if (tid < DV) ngs[tid] = P.ng[h * DV + tid];
    lds_barrier();
}

template <int DV, bool GATED, bool S2>
__device__ __forceinline__ void bla_front(LAS unsigned char* lds, const BlaRegs<DV, GATED, S2>& R, int n, int h, int tid, float (&klo)[4], float (&khi)[4], float (&qlo)[4], float (&qhi)[4]) {
    const int j = tid >> 3, sg = tid & 7;
    LAS float* bf = (LAS float*)(lds + L_BF); LAS float* bb = (LAS float*)(lds + L_BB); LAS bf16_t* vT = (LAS bf16_t*)(lds + L_VT);
    unpack4(R.k0, klo); unpack4(R.k1, khi);
    if (S2) { unpack4(R.q0, qlo); unpack4(R.q1, qhi);
#pragma unroll
        for (int e = 0; e < 4; ++e) { qlo[e] *= 0.125f; qhi[e] *= 0.125f; } }
    if (!GATED) {
        const float pos = (float)(n * 64 + j);
#pragma unroll
        for (int e = 0; e < 4; ++e) { const int i = sg * 4 + e; const float inv = __builtin_amdgcn_exp2f(-(float)i * (13.287712379549449f / 32.0f)); float s, c; sincos_turns((double)pos * (double)inv * INV2PI, s, c);
            const float a = klo[e], bq = khi[e]; klo[e] = a * c - bq * s; khi[e] = a * s + bq * c;
            if (S2) { const float a2 = qlo[e], b2 = qhi[e]; qlo[e] = a2 * c - b2 * s; qhi[e] = a2 * s + b2 * c; } }
    }
    if (S2) {
        constexpr int NV = DV / 8;
#pragma unroll
        for (int q = 0; q < NV / 8; ++q) { const u32x4 w = R.v[q]; const int e0 = sg * NV + q * 8;
            vT[(e0 + 0) * RS + j] = (bf16_t)(w.x & 0xffffu); vT[(e0 + 1) * RS + j] = (bf16_t)(w.x >> 16); vT[(e0 + 2) * RS + j] = (bf16_t)(w.y & 0xffffu); vT[(e0 + 3) * RS + j] = (bf16_t)(w.y >> 16);
            vT[(e0 + 4) * RS + j] = (bf16_t)(w.z & 0xffffu); vT[(e0 + 5) * RS + j] = (bf16_t)(w.z >> 16); vT[(e0 + 6) * RS + j] = (bf16_t)(w.w & 0xffffu); vT[(e0 + 7) * RS + j] = (bf16_t)(w.w >> 16); }
    } else {
        constexpr int NV = DV / 8, RSV = DV + 16;
#pragma unroll
        for (int q = 0; q < NV / 8; ++q) *(LAS u32x4*)(vT + j * RSV + sg * NV + q * 8) = R.v[q];
    }
    if (GATED) {
        LAS bf16_t* lra = (LAS bf16_t*)(lds + L_LR); LAS const bf16_t* wgt = (LAS const bf16_t*)(lds + L_WG); LAS const float* bgs = (LAS const float*)(lds + L_BG); LAS float* tot = (LAS float*)(lds + L_TOT);
        {
            const int lane = tid & 63, wave = tid >> 6; (void)lra;
            bf16x8 a; { const u32x4 w = R.lrf; a = __builtin_bit_cast(bf16x8, w); }
#pragma unroll
            for (int k = 0; k < 4; ++k) { const int t = wave + 8 * k, jt = t & 3, ct = t >> 2;
                const bf16x8 bq = *(LAS const bf16x8*)(wgt + (ct * 16 + (lane & 15)) * GS + (lane >> 4) * 8);
                f32x4 acc = {0.f, 0.f, 0.f, 0.f}; acc = __builtin_amdgcn_mfma_f32_16x16x32_bf16(a, bq, acc, 0, 0, 0);
                const int c = ct * 16 + (lane & 15); const float bias = bgs[c]; LAS float* dst = (c < 64 ? bf : bb) + (c & 63);
#pragma unroll
                for (int r = 0; r < 4; ++r) { const float x = acc[r] + bias; dst[(jt * 16 + (lane >> 4) * 4 + r) * 65] = (fminf(x, 0.f) - __logf(1.0f + __expf(-fabsf(x)))) * 0.0625f; } }
        }
        lds_barrier();
        {
            const int d = tid & 63, s8 = tid >> 6; float run = 0.f;
#pragma unroll
            for (int jj = 0; jj < 8; ++jj) { run += bf[(s8 * 8 + jj) * 65 + d]; bf[(s8 * 8 + jj) * 65 + d] = run; }
            tot[s8 * 64 + d] = run; run = 0.f;
#pragma unroll
            for (int jj = 7; jj >= 0; --jj) { run += bb[(s8 * 8 + jj) * 65 + d]; bb[(s8 * 8 + jj) * 65 + d] = run; }
            tot[512 + s8 * 64 + d] = run;
            lds_barrier();
            float of = 0.f, ob = 0.f;
#pragma unroll
            for (int s = 0; s < 8; ++s) { if (s < s8) of += tot[s * 64 + d]; if (s > s8) ob += tot[512 + s * 64 + d]; }
#pragma unroll
            for (int jj = 0; jj < 8; ++jj) { bf[(s8 * 8 + jj) * 65 + d] += of; bb[(s8 * 8 + jj) * 65 + d] += ob; }
        }
        lds_barrier();
    }
}

template <int DV, bool GATED>
__device__ __forceinline__ void bla_stage1(LAS unsigned char* lds, const Bla<DV, GATED>& P, int unit, const BlaRegs<DV, GATED, false>& R, int tid) {
    const int b = unit >> 8, n = (unit >> 2) & 63, h = unit & 3;
    const int lane = tid & 63, wave = tid >> 6, j = tid >> 3, sg = tid & 7;
    LAS float* bf = (LAS float*)(lds + L_BF); LAS float* bb = (LAS float*)(lds + L_BB); LAS bf16_t* vT = (LAS bf16_t*)(lds + L_VT);
    float klo[4], khi[4], qlo[4], qhi[4];
    bla_front<DV, GATED, false>(lds, R, n, h, tid, klo, khi, qlo, qhi);
    const float lgam = __logf(1.0f - __builtin_amdgcn_exp2f(-5.0f - (float)h)), cf = __expf((float)(63 - j) * lgam), cb = __expf((float)j * lgam);
    constexpr int KS = 80;
    LAS bf16_t* ksf = (LAS bf16_t*)(lds + L_QIN); LAS bf16_t* ksb = (LAS bf16_t*)(lds + L_QIN + 10240);
#pragma unroll
    for (int half = 0; half < 2; ++half) { float vf[4], vb[4];
#pragma unroll
        for (int e = 0; e < 4; ++e) { const int d = half * 32 + sg * 4 + e; const float kv = half ? khi[e] : klo[e];
            vf[e] = kv * (GATED ? __expf(bf[63 * 65 + d] - bf[j * 65 + d]) : cf); vb[e] = kv * (GATED ? __expf(bb[d] - bb[j * 65 + d]) : cb); }
        u32x2 wf, wb; wf.x = pk2(vf[0], vf[1]); wf.y = pk2(vf[2], vf[3]); wb.x = pk2(vb[0], vb[1]); wb.y = pk2(vb[2], vb[3]);
        *(LAS u32x2*)(ksf + j * KS + half * 32 + sg * 4) = wf; *(LAS u32x2*)(ksb + j * KS + half * 32 + sg * 4) = wb; }
    if (GATED && tid < 128) { const int dir = tid >> 6, d = tid & 63; P.dec[((size_t)((b * 4 + h) * 2 + dir) * 64 + n) * 64 + d] = __expf(dir ? bb[d] : bf[63 * 65 + d]); }
    lds_barrier();
    constexpr int NT = DV / 32, RSV = DV + 16;
    {
        const int g = lane >> 4, q = (lane & 15) >> 2, p = lane & 3, dt4 = wave & 3;
        const unsigned vaddr = (unsigned)(unsigned long long)(vT) + (unsigned)(((8 * g + q) * RSV + (wave >> 2) * 16 + 4 * p) * 2);
        const unsigned aaddr_f = (unsigned)(unsigned long long)(ksf) + (unsigned)(((8 * g + q) * KS + dt4 * 16 + 4 * p) * 2), aaddr_b = aaddr_f + 10240u;
        u32x2 bq[NT][2][2], af[2][2], ab[2][2];
        if constexpr (DV == 128) { asm volatile("ds_read_b64_tr_b16 %0, %20 offset:0\n\t" "ds_read_b64_tr_b16 %1, %20 offset:1152\n\t" "ds_read_b64_tr_b16 %2, %20 offset:9216\n\t" "ds_read_b64_tr_b16 %3, %20 offset:10368\n\t" "ds_read_b64_tr_b16 %4, %20 offset:64\n\t" "ds_read_b64_tr_b16 %5, %20 offset:1216\n\t" "ds_read_b64_tr_b16 %6, %20 offset:9280\n\t" "ds_read_b64_tr_b16 %7, %20 offset:10432\n\t" "ds_read_b64_tr_b16 %8, %20 offset:128\n\t" "ds_read_b64_tr_b16 %9, %20 offset:1280\n\t" "ds_read_b64_tr_b16 %10, %20 offset:9344\n\t" "ds_read_b64_tr_b16 %11, %20 offset:10496\n\t" "ds_read_b64_tr_b16 %12, %20 offset:192\n\t" "ds_read_b64_tr_b16 %13, %20 offset:1344\n\t" "ds_read_b64_tr_b16 %14, %20 offset:9408\n\t" "ds_read_b64_tr_b16 %15, %20 offset:10560\n\t" "ds_read_b64_tr_b16 %16, %21 offset:0\n\t" "ds_read_b64_tr_b16 %17, %21 offset:640\n\t" "ds_read_b64_tr_b16 %18, %21 offset:5120\n\t" "ds_read_b64_tr_b16 %19, %21 offset:5760\n\t" "s_waitcnt lgkmcnt(0)" : "=&v"(bq[0][0][0]), "=&v"(bq[0][0][1]), "=&v"(bq[0][1][0]), "=&v"(bq[0][1][1]), "=&v"(bq[1][0][0]), "=&v"(bq[1][0][1]), "=&v"(bq[1][1][0]), "=&v"(bq[1][1][1]), "=&v"(bq[2][0][0]), "=&v"(bq[2][0][1]), "=&v"(bq[2][1][0]), "=&v"(bq[2][1][1]), "=&v"(bq[3][0][0]), "=&v"(bq[3][0][1]), "=&v"(bq[3][1][0]), "=&v"(bq[3][1][1]), "=&v"(af[0][0]), "=&v"(af[0][1]), "=&v"(af[1][0]), "=&v"(af[1][1]) : "v"(vaddr), "v"(aaddr_f) : "memory");
            asm volatile("ds_read_b64_tr_b16 %0, %4 offset:0\n\t" "ds_read_b64_tr_b16 %1, %4 offset:640\n\t" "ds_read_b64_tr_b16 %2, %4 offset:5120\n\t" "ds_read_b64_tr_b16 %3, %4 offset:5760\n\t" "s_waitcnt lgkmcnt(0)" : "=&v"(ab[0][0]), "=&v"(ab[0][1]), "=&v"(ab[1][0]), "=&v"(ab[1][1]) : "v"(aaddr_b) : "memory"); }
        else { asm volatile("ds_read_b64_tr_b16 %0, %12 offset:0\n\t" "ds_read_b64_tr_b16 %1, %12 offset:640\n\t" "ds_read_b64_tr_b16 %2, %12 offset:5120\n\t" "ds_read_b64_tr_b16 %3, %12 offset:5760\n\t" "ds_read_b64_tr_b16 %4, %12 offset:64\n\t" "ds_read_b64_tr_b16 %5, %12 offset:704\n\t" "ds_read_b64_tr_b16 %6, %12 offset:5184\n\t" "ds_read_b64_tr_b16 %7, %12 offset:5824\n\t" "ds_read_b64_tr_b16 %8, %13 offset:0\n\t" "ds_read_b64_tr_b16 %9, %13 offset:640\n\t" "ds_read_b64_tr_b16 %10, %13 offset:5120\n\t" "ds_read_b64_tr_b16 %11, %13 offset:5760\n\t" "s_waitcnt lgkmcnt(0)" : "=&v"(bq[0][0][0]), "=&v"(bq[0][0][1]), "=&v"(bq[0][1][0]), "=&v"(bq[0][1][1]), "=&v"(bq[1][0][0]), "=&v"(bq[1][0][1]), "=&v"(bq[1][1][0]), "=&v"(bq[1][1][1]), "=&v"(af[0][0]), "=&v"(af[0][1]), "=&v"(af[1][0]), "=&v"(af[1][1]) : "v"(vaddr), "v"(aaddr_f) : "memory");
            asm volatile("ds_read_b64_tr_b16 %0, %4 offset:0\n\t" "ds_read_b64_tr_b16 %1, %4 offset:640\n\t" "ds_read_b64_tr_b16 %2, %4 offset:5120\n\t" "ds_read_b64_tr_b16 %3, %4 offset:5760\n\t" "s_waitcnt lgkmcnt(0)" : "=&v"(ab[0][0]), "=&v"(ab[0][1]), "=&v"(ab[1][0]), "=&v"(ab[1][1]) : "v"(aaddr_b) : "memory"); }
#pragma unroll
        for (int dir = 0; dir < 2; ++dir) {
            bf16_t* stb = P.st + ((size_t)((b * 4 + h) * 2 + dir) * 64 + n) * (DV * 64);
#pragma unroll
            for (int k = 0; k < NT; ++k) { const int et = (wave >> 2) + 2 * k; f32x4 acc = {0.f, 0.f, 0.f, 0.f};
#pragma unroll
                for (int kb = 0; kb < 2; ++kb) { const u32x2 a0 = dir ? ab[kb][0] : af[kb][0], a1 = dir ? ab[kb][1] : af[kb][1];
                    const u32x4 aw = {a0.x, a0.y, a1.x, a1.y}, bw = {bq[k][kb][0].x, bq[k][kb][0].y, bq[k][kb][1].x, bq[k][kb][1].y};
                    acc = __builtin_amdgcn_mfma_f32_16x16x32_bf16(__builtin_bit_cast(bf16x8, aw), __builtin_bit_cast(bf16x8, bw), acc, 0, 0, 0); }
                u32x2 w; w.x = pk2(acc[0], acc[1]); w.y = pk2(acc[2], acc[3]);
                *(u32x2*)(stb + (et * 16 + (lane & 15)) * 64 + dt4 * 16 + (lane >> 4) * 4) = w; }
        }
    }
    lds_barrier();
}

template <int DV, bool GATED>
__device__ __forceinline__ void bla_stage2(LAS unsigned char* lds, const Bla<DV, GATED>& P, int unit, const BlaRegs<DV, GATED, true>& R, int tid) {
    const int b = unit >> 8, n = (unit >> 2) & 63, h = unit & 3;
    const int lane = tid & 63, wave = tid >> 6, j = tid >> 3, sg = tid & 7; const int tok0 = b * SEQ + n * 64;
    LAS float* bf = (LAS float*)(lds + L_BF); LAS float* bb = (LAS float*)(lds + L_BB); LAS bf16_t* vT = (LAS bf16_t*)(lds + L_VT);
    LAS bf16_t* qin = (LAS bf16_t*)(lds + L_QIN); LAS bf16_t* kin = (LAS bf16_t*)(lds + L_KIN); LAS bf16_t* Pm = (LAS bf16_t*)(lds + L_P); LAS bf16_t* ST = (LAS bf16_t*)(lds + L_ST);
    float klo[4], khi[4], qlo[4], qhi[4];
    bla_front<DV, GATED, true>(lds, R, n, h, tid, klo, khi, qlo, qhi);
    const float lgam = __logf(1.0f - __builtin_amdgcn_exp2f(-5.0f - (float)h));
    constexpr int NT = DV / 32;
    f32x4 oacc[NT];
#pragma unroll
    for (int k = 0; k < NT; ++k) oacc[k] = (f32x4){0.f, 0.f, 0.f, 0.f};
    constexpr bool BOTH = !GATED;
    LAS bf16_t* const qin2[2] = {qin, BOTH ? (LAS bf16_t*)(lds + L_BF) : qin};
    LAS bf16_t* const kin2[2] = {kin, BOTH ? (LAS bf16_t*)(lds + L_BF + 9216) : kin};
    LAS bf16_t* const Pm2[2] = {Pm, BOTH ? (LAS bf16_t*)(lds + L_BF + 18432) : Pm};
    LAS bf16_t* const ST2[2] = {ST, BOTH ? ST + 64 * RS : ST};
#define BLA_STEP_A(dir) do { LAS const float* bx = (dir) ? bb : bf; \
        const float bret = (float)((dir) ? 64 - j : j + 1) * lgam, eq = __expf(bret), ek = __expf(-bret); \
        _Pragma("unroll") for (int half = 0; half < 2; ++half) { float qv[4], kv4[4]; \
            _Pragma("unroll") for (int e = 0; e < 4; ++e) { const int d = half * 32 + sg * 4 + e; \
                if (GATED) { const float bv = bx[j * 65 + d]; qv[e] = (half ? qhi[e] : qlo[e]) * __expf(bv); kv4[e] = (half ? khi[e] : klo[e]) * __expf(-bv); } \
                else { qv[e] = (half ? qhi[e] : qlo[e]) * eq; kv4[e] = (half ? khi[e] : klo[e]) * ek; } } \
            u32x2 wq, wk; wq.x = pk2(qv[0], qv[1]); wq.y = pk2(qv[2], qv[3]); wk.x = pk2(kv4[0], kv4[1]); wk.y = pk2(kv4[2], kv4[3]); \
            *(LAS u32x2*)(qin2[dir] + j * RS + half * 32 + sg * 4) = wq; *(LAS u32x2*)(kin2[dir] + j * RS + half * 32 + sg * 4) = wk; } \
        _Pragma("unroll") for (int q = 0; q < DV / 64; ++q) { const int sgi = tid + 512 * q, e = sgi >> 3, d8 = (sgi & 7) * 8; *(LAS u32x4*)(ST2[dir] + e * RS + d8) = R.st[dir][q]; } } while (0)
#define BLA_STEP_B(dir) do { \
        _Pragma("unroll") for (int k = 0; k < 2; ++k) { const int t = wave + 8 * k, it = t & 3, jt = t >> 2; f32x4 acc = {0.f, 0.f, 0.f, 0.f}; \
            _Pragma("unroll") for (int kb = 0; kb < 2; ++kb) acc = __builtin_amdgcn_mfma_f32_16x16x32_bf16(frag(qin2[dir], it * 16, kb, lane), frag(kin2[dir], jt * 16, kb, lane), acc, 0, 0, 0); \
            const int jj = jt * 16 + (lane & 15); \
            _Pragma("unroll") for (int r = 0; r < 4; ++r) { const int ii = it * 16 + (lane >> 4) * 4 + r; const bool keep = (dir) ? (jj > ii) : (jj <= ii); Pm2[dir][ii * RS + jj] = (bf16_t)f2bf(keep ? acc[r] : 0.f); } } } while (0)
#define BLA_STEP_C(dir) do { \
        _Pragma("unroll") for (int k = 0; k < NT; ++k) { const int t = wave + 8 * k, it = t & 3, et = t >> 2; \
            _Pragma("unroll") for (int kb = 0; kb < 2; ++kb) oacc[k] = __builtin_amdgcn_mfma_f32_16x16x32_bf16(frag(Pm2[dir], it * 16, kb, lane), frag(vT, et * 16, kb, lane), oacc[k], 0, 0, 0); \
            _Pragma("unroll") for (int kb = 0; kb < 2; ++kb) oacc[k] = __builtin_amdgcn_mfma_f32_16x16x32_bf16(frag(qin2[dir], it * 16, kb, lane), frag(ST2[dir], et * 16, kb, lane), oacc[k], 0, 0, 0); } } while (0)
    if constexpr (BOTH) {
        BLA_STEP_A(0); BLA_STEP_A(1); lds_barrier();
        BLA_STEP_B(0); BLA_STEP_B(1); lds_barrier();
        BLA_STEP_C(0); BLA_STEP_C(1); lds_barrier();
    } else {
        BLA_STEP_A(0); lds_barrier(); BLA_STEP_B(0); lds_barrier(); BLA_STEP_C(0); lds_barrier();
        BLA_STEP_A(1); lds_barrier(); BLA_STEP_B(1); lds_barrier(); BLA_STEP_C(1); lds_barrier();
    }
#undef BLA_STEP_A
#undef BLA_STEP_B
#undef BLA_STEP_C
    constexpr int OS = DV + 4; LAS float* ob = (LAS float*)lds; LAS const float* ngs = (LAS const float*)(lds + L_NG);
#pragma unroll
    for (int k = 0; k < NT; ++k) { const int t = wave + 8 * k, it = t & 3, et = t >> 2;
#pragma unroll
        for (int r = 0; r < 4; ++r) ob[(it * 16 + (lane >> 4) * 4 + r) * OS + et * 16 + (lane & 15)] = oacc[k][r]; }
    lds_barrier();
    {
        constexpr int NV = DV / 8; float v[NV]; float s = 0.f;
#pragma unroll
        for (int e = 0; e < NV; ++e) { v[e] = ob[j * OS + sg * NV + e]; s += v[e]; }
        if (!GATED) { s += shx(s, 1, lane); s += shx(s, 2, lane); s += shx(s, 4, lane); const float mean = s * (1.0f / DV);
#pragma unroll
            for (int e = 0; e < NV; ++e) v[e] -= mean; }
        float q = 0.f;
#pragma unroll
        for (int e = 0; e < NV; ++e) q += v[e] * v[e];
        q += shx(q, 1, lane); q += shx(q, 2, lane); q += shx(q, 4, lane);
        const float rs = __builtin_amdgcn_rsqf(q * (1.0f / DV) + EPS);
        bf16_t* op = P.out + (size_t)(tok0 + j) * P.ldo + h * DV + sg * NV;
#pragma unroll
        for (int q8 = 0; q8 < NV / 8; ++q8) { const u32x4 gw = R.og[q8]; float gt[8];
            gt[0] = bf2f(gw.x & 0xffffu); gt[1] = bf2f(gw.x >> 16); gt[2] = bf2f(gw.y & 0xffffu); gt[3] = bf2f(gw.y >> 16); gt[4] = bf2f(gw.z & 0xffffu); gt[5] = bf2f(gw.z >> 16); gt[6] = bf2f(gw.w & 0xffffu); gt[7] = bf2f(gw.w >> 16);
            float r[8];
#pragma unroll
            for (int e = 0; e < 8; ++e) { const float y = v[q8 * 8 + e] * rs * ngs[sg * NV + q8 * 8 + e]; r[e] = y * gt[e] * sigmoidf_(gt[e]); }
            u32x4 w; w.x = pk2(r[0], r[1]); w.y = pk2(r[2], r[3]); w.z = pk2(r[4], r[5]); w.w = pk2(r[6], r[7]);
            *(u32x4*)(op + q8 * 8) = w; }
    }
    lds_barrier();
}
template <int DV, bool GATED>
__device__ __forceinline__ void bla_phase1(LAS unsigned char* lds, const Bla<DV, GATED>& P, const int wv) {
    const int tid = ltid(wv), G = lgdim(); int u = lbid(), hl = -1;
    BlaRegs<DV, GATED, false> cur, nx1, nx2;
    if (u < 4096) bla_issue<DV, GATED, false>(P, u, tid, cur);
    if (u + G < 4096) bla_issue<DV, GATED, false>(P, u + G, tid, nx1);
    for (; u < 4096; u += G) {
        if (u + 2 * G < 4096) bla_issue<DV, GATED, false>(P, u + 2 * G, tid, nx2);
        if ((u & 3) != hl) { hl = u & 3; bla_head_consts<DV, GATED>(lds, P, hl, tid); }
        bla_stage1<DV, GATED>(lds, P, u, cur, tid);
        cur = nx1; nx1 = nx2;
    }
}
template <int DV, bool GATED>
__device__ __forceinline__ void bla_phase2(LAS unsigned char* lds, const Bla<DV, GATED>& P, const int wv) {
    const int tid = ltid(wv), G = lgdim(); int u = lbid(), hl = -1;
    BlaRegs<DV, GATED, true> cur, nx1, nx2;
    if (u < 4096) bla_issue<DV, GATED, true>(P, u, tid, cur);
    if (u + G < 4096) bla_issue<DV, GATED, true>(P, u + G, tid, nx1);
    for (; u < 4096; u += G) {
        if (u + 2 * G < 4096) bla_issue<DV, GATED, true>(P, u + 2 * G, tid, nx2);
        if ((u & 3) != hl) { hl = u & 3; bla_head_consts<DV, GATED>(lds, P, hl, tid); }
        bla_stage2<DV, GATED>(lds, P, u, cur, tid);
        cur = nx1; nx1 = nx2;
    }
}

__device__ __forceinline__ void bla_scan_pair(int gi, int ri, int si, bf16_t* gst, const float* gdec, bf16_t* rst, const S5In p, int l, const float* Xl, bf16_t* Uc) {
    const int gd8 = gi & 7, ge = (gi >> 3) & 127, gbhd = gi >> 10, gdir = gbhd & 1;
    bf16_t* gbase = gst + (size_t)gbhd * 64 * 128 * 64 + ge * 64 + gd8 * 8; const float* dbase = gdec + (size_t)gbhd * 64 * 64 + gd8 * 8;
    const bool hasr = ri >= 0; const int rr = hasr ? ri : 0;
    const int rd8 = rr & 7, re = (rr >> 3) & 63, rbhd = rr >> 9, rdir = rbhd & 1, rh = (rbhd >> 1) & 3;
    bf16_t* rbase = rst + (size_t)rbhd * 64 * 64 * 64 + re * 64 + rd8 * 8;
    const float cdec = __expf(64.0f * __logf(1.0f - __builtin_amdgcn_exp2f(-5.0f - (float)rh)));
    float S[8], T[8];
#pragma unroll
    for (int k = 0; k < 8; ++k) { S[k] = 0.f; T[k] = 0.f; }
    const bool hass = si >= 0; const int sx = hass ? si : 0;
    const int spp = sx & 63, sdir = (sx >> 6) & 1, sg5 = (sx >> 7) & 15, sb = sx >> 11;
    float Lr = 0.f, Li = 0.f, xr = 0.f, xi = 0.f;
    if (hass) { const float lr = p.lam_re[(size_t)l * 2048 + (sdir * 16 + sg5) * 64 + spp], li = p.lam_im[(size_t)l * 2048 + (sdir * 16 + sg5) * 64 + spp], dt = __expf(p.log_dt[l * 32 + sdir * 16 + sg5]);
        const float mag = __expf(lr * dt * 64.f); float sn, cs; sincos_turns((double)li * (double)dt * 64.0 * INV2PI, sn, cs); Lr = mag * cs; Li = mag * sn; }
    const size_t srow0 = (size_t)sg5 * 1024 + sb * 64;
#pragma unroll 1
    for (int bt = 0; bt < 8; ++bt) {
        u32x4 kw[8], rw[8]; f32x4 d0[8], d1[8];
#pragma unroll
        for (int s = 0; s < 8; ++s) { const int stp = bt * 8 + s, n = gdir ? 63 - stp : stp, nr = rdir ? 63 - stp : stp;
            kw[s] = *(const u32x4*)(gbase + (size_t)n * 8192); d0[s] = *(const f32x4*)(dbase + n * 64); d1[s] = *(const f32x4*)(dbase + n * 64 + 4);
            rw[s] = hasr ? *(const u32x4*)(rbase + (size_t)nr * 4096) : (u32x4){0u, 0u, 0u, 0u}; }
        float ar[8], ai[8];
#pragma unroll
        for (int s = 0; s < 8; ++s) { const int stp = bt * 8 + s, n5 = sdir ? 63 - stp : stp; ar[s] = hass ? Xl[(srow0 + n5) * 256 + sdir * 128 + spp] : 0.f; ai[s] = hass ? Xl[(srow0 + n5) * 256 + sdir * 128 + 64 + spp] : 0.f; }
#pragma unroll
        for (int s = 0; s < 8; ++s) { const int stp = bt * 8 + s, n = gdir ? 63 - stp : stp, nr = rdir ? 63 - stp : stp;
            { u32x4 w; w.x = pk2(S[0], S[1]); w.y = pk2(S[2], S[3]); w.z = pk2(S[4], S[5]); w.w = pk2(S[6], S[7]); *(u32x4*)(gbase + (size_t)n * 8192) = w; }
            const u32x4 k4 = kw[s];
            S[0] = d0[s][0] * S[0] + bf2f(k4.x & 0xffffu); S[1] = d0[s][1] * S[1] + bf2f(k4.x >> 16); S[2] = d0[s][2] * S[2] + bf2f(k4.y & 0xffffu); S[3] = d0[s][3] * S[3] + bf2f(k4.y >> 16);
            S[4] = d1[s][0] * S[4] + bf2f(k4.z & 0xffffu); S[5] = d1[s][1] * S[5] + bf2f(k4.z >> 16); S[6] = d1[s][2] * S[6] + bf2f(k4.w & 0xffffu); S[7] = d1[s][3] * S[7] + bf2f(k4.w >> 16);
            if (hasr) { u32x4 w; w.x = pk2(T[0], T[1]); w.y = pk2(T[2], T[3]); w.z = pk2(T[4], T[5]); w.w = pk2(T[6], T[7]); *(u32x4*)(rbase + (size_t)nr * 4096) = w;
                const u32x4 r4 = rw[s];
                T[0] = cdec * T[0] + bf2f(r4.x & 0xffffu); T[1] = cdec * T[1] + bf2f(r4.x >> 16); T[2] = cdec * T[2] + bf2f(r4.y & 0xffffu); T[3] = cdec * T[3] + bf2f(r4.y >> 16);
                T[4] = cdec * T[4] + bf2f(r4.z & 0xffffu); T[5] = cdec * T[5] + bf2f(r4.z >> 16); T[6] = cdec * T[6] + bf2f(r4.w & 0xffffu); T[7] = cdec * T[7] + bf2f(r4.w >> 16); }
            if (hass) { const int n5 = sdir ? 63 - stp : stp;
                Uc[(srow0 + n5) * 1280 + 1024 + sdir * 128 + spp] = (bf16_t)f2bf(xr); Uc[(srow0 + n5) * 1280 + 1024 + sdir * 128 + 64 + spp] = (bf16_t)f2bf(xi);
                const float nr2 = Lr * xr - Li * xi + ar[s], ni2 = Lr * xi + Li * xr + ai[s]; xr = nr2; xi = ni2; } }
    }
}
__device__ __forceinline__ void s5_scan_item(const S5In p, int l, int idx, const float* Xl, bf16_t* Uc) {
    const int pp = idx & 63, dir = (idx >> 6) & 1, g = (idx >> 7) & 15, b = idx >> 11;
    const float lr = p.lam_re[(size_t)l * 2048 + (dir * 16 + g) * 64 + pp], li = p.lam_im[(size_t)l * 2048 + (dir * 16 + g) * 64 + pp], dt = __expf(p.log_dt[l * 32 + dir * 16 + g]);
    const float mag = __expf(lr * dt * 64.f); float s, cs; sincos_turns((double)li * (double)dt * 64.0 * INV2PI, s, cs);
    const float Lr = mag * cs, Li = mag * s; float xr = 0.f, xi = 0.f;
    const size_t row0 = (size_t)g * 1024 + b * 64;
#pragma unroll 1
    for (int bt = 0; bt < 4; ++bt) { float ar[16], ai[16];
#pragma unroll
        for (int q = 0; q < 16; ++q) { const int st = bt * 16 + q, n = dir ? 63 - st : st; ar[q] = Xl[(row0 + n) * 256 + dir * 128 + pp]; ai[q] = Xl[(row0 + n) * 256 + dir * 128 + 64 + pp]; }
#pragma unroll
        for (int q = 0; q < 16; ++q) { const int st = bt * 16 + q, n = dir ? 63 - st : st;
            Uc[(row0 + n) * 1280 + 1024 + dir * 128 + pp] = (bf16_t)f2bf(xr); Uc[(row0 + n) * 1280 + 1024 + dir * 128 + 64 + pp] = (bf16_t)f2bf(xi);
            const float nr = Lr * xr - Li * xi + ar[q], ni = Lr * xi + Li * xr + ai[q]; xr = nr; xi = ni; } }
}
__device__ __forceinline__ void scan_phase(const S5In p, int l, const float* Xl, bf16_t* Uc, bf16_t* gst, const float* gdec, bf16_t* rst, const int wv) {
    const int tid = ltid(wv), G = lgdim(), blk = lbid();
    for (int base = blk; base < 256; base += G) {
        const int gi = base * 512 + tid, ri = tid < 256 ? base * 256 + tid : -1;
        bla_scan_pair(gi, ri, tid >= 384 ? base * 128 + (tid - 384) : -1, gst, gdec, rst, p, l, Xl, Uc);
    }
}

typedef const Params __attribute__((address_space(4)))* PP;
__device__ __forceinline__ PP fresh_params() {
    unsigned long long ka = (unsigned long long)__builtin_amdgcn_kernarg_segment_ptr();
    asm volatile("" : "+s"(ka));
    return (PP)ka;
}
#define WSP(T, off) ((T*)(pp->ws + (off)))
#define XB_TMO      128
#define XB_XCNT(j)  (256  + 64 * (j))
#define XB_XSUB(j)  (1280 + 64 * (j))
#define XB_XGEN(j)  (2304 + 64 * (j))
#define XB_TOP      3328
#define XB_TOPGEN   3392
#define XCD_BAR_WORDS 3456
#define XB_SPIN_CAP (1u << 18)
__device__ __forceinline__ unsigned xb_ld(unsigned* p)              { return __hip_atomic_load(p, __ATOMIC_RELAXED, __HIP_MEMORY_SCOPE_AGENT); }
__device__ __forceinline__ unsigned xb_add(unsigned* p, unsigned v) { return __hip_atomic_fetch_add(p, v, __ATOMIC_RELAXED, __HIP_MEMORY_SCOPE_AGENT); }
__device__ __forceinline__ unsigned xb_xcc_id() { return (unsigned)__builtin_amdgcn_s_getreg((3 << 11) | 20) & 0xFu; }
#define XB_SPIN(cond, bar) do { unsigned _sp = 0; while (cond) { __builtin_amdgcn_s_sleep(1); \
    if ((++_sp & 255u) == 0u) { if (xb_ld(&(bar)[XB_TMO])) break; if (_sp > XB_SPIN_CAP) { atomicAdd(&(bar)[XB_TMO], 1u); break; } } } } while (0)
__device__ __forceinline__ void xcd_barrier_complete(unsigned* bar, unsigned x, unsigned G, unsigned& nloc, unsigned& nx) {
    unsigned sum, cnt, mine, sp = 0u;
    for (;;) {
        sum = 0u; cnt = 0u; mine = 0u;
#pragma unroll
        for (unsigned j = 0; j < 16; ++j) { const unsigned c = xb_ld(&bar[XB_XCNT(j)]); sum += c; cnt += (c > 0u) ? 1u : 0u; mine = (j == x) ? c : mine; }
        if (sum == G) break;
        __builtin_amdgcn_s_sleep(1);
        if ((++sp & 255u) == 0u) { if (xb_ld(&bar[XB_TMO])) break; if (sp > XB_SPIN_CAP) { atomicAdd(&bar[XB_TMO], 1u); break; } }
    }
    nloc = mine > 0u ? mine : 1u; nx = cnt > 0u ? cnt : 1u;
}
__device__ __forceinline__ void grid_barrier(unsigned* bar, volatile LAS unsigned* st, const int wv) {
    asm volatile("s_waitcnt vmcnt(0) lgkmcnt(0)" ::: "memory");
    __syncthreads();
    if (ltid(wv) == 0) {
        const unsigned x = xb_xcc_id();
        __builtin_amdgcn_s_waitcnt(0);
        unsigned nloc = st[0], nx = st[1];
        if (nloc == 0u) { xcd_barrier_complete(bar, x, (unsigned)lgdim(), nloc, nx); st[0] = nloc; st[1] = nx; }
        const unsigned old = xb_add(&bar[XB_XSUB(x)], 1u);
        const unsigned gen = old / nloc;
        if (old + 1u == (gen + 1u) * nloc) {
            __builtin_amdgcn_fence(__ATOMIC_RELEASE, "agent");
            asm volatile("s_waitcnt vmcnt(0)" ::: "memory");
            const unsigned og = xb_add(&bar[XB_TOP], 1u);
            const unsigned tg = og / nx;
            if (og + 1u == (tg + 1u) * nx) xb_add(&bar[XB_TOPGEN], 1u);
            else XB_SPIN(xb_ld(&bar[XB_TOPGEN]) == tg, bar);
            __builtin_amdgcn_fence(__ATOMIC_ACQUIRE, "agent");
            xb_add(&bar[XB_XGEN(x)], 1u);
            asm volatile("s_waitcnt vmcnt(0)" ::: "memory");
        } else {
            XB_SPIN(xb_ld(&bar[XB_XGEN(x)]) == gen, bar);
            __builtin_amdgcn_fence(__ATOMIC_ACQUIRE, "agent");
            asm volatile("s_waitcnt vmcnt(0)" ::: "memory");
        }
    }
    __syncthreads();
}
#define GSYNC(i) do { PP pq = fresh_params(); grid_barrier((unsigned*)(pq->ws + WS_CTL), (volatile LAS unsigned*)(lds + 131072), wv); } while (0)

__global__ void __launch_bounds__(512, 2) fwd_megakernel(Params p_unused) {
    extern __shared__ __attribute__((aligned(16))) unsigned char lds_raw[];
    LAS unsigned char* lds = (LAS unsigned char*)lds_raw;
    const int wv = __builtin_amdgcn_readfirstlane((int)(threadIdx.x >> 6));
    if (threadIdx.x < 4) ((volatile LAS unsigned*)(lds + 131072))[threadIdx.x] = 0u;
    if (blockIdx.x == 0) { PP pz = fresh_params(); unsigned* bz = (unsigned*)(pz->ws + WS_CTL);
        for (int i = threadIdx.x; i < XCD_BAR_WORDS; i += 512) __hip_atomic_store(bz + i, 0u, __ATOMIC_RELAXED, __HIP_MEMORY_SCOPE_AGENT); }
    cg::this_grid().sync();
    if (threadIdx.x == 0) { PP pz = fresh_params(); (void)xb_add((unsigned*)(pz->ws + WS_CTL) + XB_XCNT(xb_xcc_id()), 1u); }

#pragma unroll 1
    for (int l = 0; l < DEPTH; ++l) {
#if !defined(NO_CONV)
        { PP pp = fresh_params(); conv_T(lds, pp->in[2] + (size_t)l * DM * 2832, DM, 2832, WSP(bf16_t, WS_WZ), 3072, MapZ(), wv); }
        { PP pp = fresh_params(); conv_T(lds, pp->in[18] + (size_t)l * DM * 3072, DM, 3072, WSP(bf16_t, WS_WG), 3072, MapId(), wv); }
        { PP pp = fresh_params(); conv_T(lds, pp->in[15] + (size_t)l * 256 * DM, 256, DM, WSP(bf16_t, WS_WA), DM, MapId(), wv); }
        { PP pp = fresh_params(); conv_T(lds, pp->in[16] + (size_t)l * 256 * 2048, 256, 2048, WSP(bf16_t, WS_WB), 2048, MapGLU(), wv); }
        { PP pp = fresh_params(); conv_T(lds, pp->in[17] + (size_t)l * 512 * DM, 512, DM, WSP(bf16_t, WS_WC), DM, MapId(), wv); }
        { PP pp = fresh_params(); conv_T(lds, pp->in[20] + (size_t)l * DM * DM, DM, DM, WSP(bf16_t, WS_WO), DM, MapId(), wv); }
        { PP pp = fresh_params(); conv_T(lds, pp->in[22] + (size_t)l * DM * DFF, DM, DFF, WSP(bf16_t, WS_W1), DFF, MapId(), wv); }
        { PP pp = fresh_params(); conv_T(lds, pp->in[23] + (size_t)l * DFF * DM, DFF, DM, WSP(bf16_t, WS_W2), DM, MapId(), wv); }
#endif
#if !defined(NO_PREP)
        { PP pp = fresh_params(); const S5In si{pp->in[4], pp->in[5], pp->in[6], pp->in[7], pp->in[8], pp->in[9], pp->in[10], pp->in[11]}; for (int u = lbid(); u < 256; u += lgdim()) s5_prep(lds, si, l, u, WSP(bf16_t, WS_T1), WSP(bf16_t, WS_T2), wv); }
#endif
        { PP pp = fresh_params(); if (l == 0) prep0_phase(pp->in[0], pp->in[1], WSP(bf16_t, WS_H), WSP(float, WS_RS1), wv); else rs_phase(WSP(float, WS_SL1), WSP(float, WS_RS1), wv); }
        GSYNC(0);
        { PP pp = fresh_params(); pg8::OrderStd S; S.init(WSP(bf16_t, WS_H), DM, WSP(bf16_t, WS_WZ), DM, NTOK, 3072); pg8::EpiZ E{WSP(bf16_t, WS_Z), WSP(bf16_t, WS_UC), WSP(float, WS_RS1)}; pg8::gemm_phase(lds, S, E, DM, DM, DM, wv); }
        GSYNC(1);
        { PP pp = fresh_params(); pg8::OrderBatch S; S.init(WSP(bf16_t, WS_UC), 1280, (size_t)1024 * 1280 * 2, WSP(bf16_t, WS_T1), 1024, (size_t)256 * 1024 * 2, 4, 1); pg8::EpiXloc E{WSP(float, WS_XL)}; pg8::gemm_phase(lds, S, E, 1024, 1280, 1024, wv); }
#if !defined(NO_BLA1)
        { PP pp = fresh_params(); Bla<64, false> PA{WSP(bf16_t, WS_Z) + ZR_OFF, nullptr, nullptr, nullptr, WSP(bf16_t, WS_RST), nullptr, pp->in[3] + l * 256, WSP(bf16_t, WS_RO), 256};
          bla_phase1<64, false>(lds, PA, wv); }
        { PP pp = fresh_params(); Bla<128, true> PC{WSP(bf16_t, WS_Z) + ZG_OFF, WSP(bf16_t, WS_Z) + ZL_OFF, pp->in[12] + (size_t)l * 2 * 16 * 256, pp->in[13] + l * 512, WSP(bf16_t, WS_GST), WSP(float, WS_GDEC), pp->in[14] + l * 512, WSP(bf16_t, WS_GO), 512};
          bla_phase1<128, true>(lds, PC, wv); }
#endif
        GSYNC(2);
#if !defined(NO_SCAN)
        { PP pp = fresh_params(); const S5In si{pp->in[4], pp->in[5], pp->in[6], pp->in[7], pp->in[8], pp->in[9], pp->in[10], pp->in[11]}; scan_phase(si, l, WSP(float, WS_XL), WSP(bf16_t, WS_UC), WSP(bf16_t, WS_GST), WSP(float, WS_GDEC), WSP(bf16_t, WS_RST), wv); }
#endif
        GSYNC(3);
        { PP pp = fresh_params(); pg8::OrderBatch S; S.init(WSP(bf16_t, WS_UC), 1280, (size_t)1024 * 1280 * 2, WSP(bf16_t, WS_T2), 1280, (size_t)1024 * 1280 * 2, 4, 4); pg8::EpiS5Y E{WSP(bf16_t, WS_Y)}; pg8::gemm_phase(lds, S, E, 1280, 1280, 1280, wv); }
#if !defined(NO_BLA2)
        { PP pp = fresh_params(); Bla<64, false> PA{WSP(bf16_t, WS_Z) + ZR_OFF, nullptr, nullptr, nullptr, WSP(bf16_t, WS_RST), nullptr, pp->in[3] + l * 256, WSP(bf16_t, WS_RO), 256};
          bla_phase2<64, false>(lds, PA, wv); }
        { PP pp = fresh_params(); Bla<128, true> PC{WSP(bf16_t, WS_Z) + ZG_OFF, WSP(bf16_t, WS_Z) + ZL_OFF, pp->in[12] + (size_t)l * 2 * 16 * 256, pp->in[13] + l * 512, WSP(bf16_t, WS_GST), WSP(float, WS_GDEC), pp->in[14] + l * 512, WSP(bf16_t, WS_GO), 512};
          bla_phase2<128, true>(lds, PC, wv); }
#endif
        GSYNC(4);
        { PP pp = fresh_params(); pg8::OrderStd S; S.init(WSP(bf16_t, WS_RO), 256, WSP(bf16_t, WS_WA), 256, NTOK, DM); pg8::EpiBf16<0> E{WSP(bf16_t, WS_Z), DM}; pg8::gemm_phase(lds, S, E, 256, 256, 256, wv); }
        { PP pp = fresh_params(); pg8::OrderStd S; S.init(WSP(bf16_t, WS_Y), 256, WSP(bf16_t, WS_WB), 256, NTOK, 2048); pg8::EpiGLU E{WSP(bf16_t, WS_Z) + (size_t)NTOK * DM}; pg8::gemm_phase(lds, S, E, 256, 256, 256, wv); }
        { PP pp = fresh_params(); pg8::OrderStd S; S.init(WSP(bf16_t, WS_GO), 512, WSP(bf16_t, WS_WC), 512, NTOK, DM); pg8::EpiBf16<0> E{WSP(bf16_t, WS_Z) + (size_t)2 * NTOK * DM, DM}; pg8::gemm_phase(lds, S, E, 512, 512, 512, wv); }
        GSYNC(5);
        { PP pp = fresh_params(); pg8::OrderMerge S; S.init(WSP(bf16_t, WS_H), DM, WSP(bf16_t, WS_WG), DM, NTOK); pg8::EpiMerge E{WSP(bf16_t, WS_Z), WSP(bf16_t, WS_GST), pp->in[19] + (size_t)l * 3072, WSP(float, WS_RS1)}; pg8::gemm_phase(lds, S, E, DM, DM, DM, wv); }
        GSYNC(6);
        { PP pp = fresh_params(); pg8::OrderStd S; S.init(WSP(bf16_t, WS_GST), DM, WSP(bf16_t, WS_WO), DM, NTOK, DM); pg8::EpiResNorm<false> E{l == 0 ? pp->in[0] : pp->out, pp->out, WSP(bf16_t, WS_H), pp->in[21] + l * DM, WSP(float, WS_SL2), nullptr}; pg8::gemm_phase(lds, S, E, DM, DM, DM, wv); }
        GSYNC(7);
        { PP pp = fresh_params(); rs_phase(WSP(float, WS_SL2), WSP(float, WS_RS2), wv); }
        { PP pp = fresh_params(); pg8::OrderStd S; S.init(WSP(bf16_t, WS_H), DM, WSP(bf16_t, WS_W1), DM, NTOK, DFF); pg8::EpiBf16<1> E{WSP(bf16_t, WS_Z), DFF}; pg8::gemm_phase(lds, S, E, DM, DM, DM, wv); }
        GSYNC(9);
        { PP pp = fresh_params(); pg8::OrderStd S; S.init(WSP(bf16_t, WS_Z), DFF, WSP(bf16_t, WS_W2), DFF, NTOK, DM); pg8::EpiResNorm<true> E{pp->out, pp->out, l + 1 < DEPTH ? WSP(bf16_t, WS_H) : nullptr, pp->in[1] + (l + 1 < DEPTH ? (l + 1) * DM : 0), WSP(float, WS_SL1), WSP(float, WS_RS2)}; pg8::gemm_phase(lds, S, E, DFF, DFF, DFF, wv); }
        GSYNC(10);
    }
    { PP pp = fresh_params(); final_norm_phase(pp->out, pp->in[24], WSP(float, WS_SL1), wv); }
}

extern "C" void kernel_launch(void* const* d_in, const int* in_sizes, int n_in, void* d_out, int out_size, void* d_ws, size_t ws_size, hipStream_t stream) {
    static int grid_blocks = 0;
    if (grid_blocks == 0) {
        if (n_in != 25 || out_size != NTOK * DM || ws_size < WS_END) { fprintf(stderr, "kernel_launch: unexpected shapes (n_in %d out %d ws %zu need %zu)\n", n_in, out_size, ws_size, (size_t)WS_END); grid_blocks = -1; return; }
        int dev = 0, cus = 0, per_cu = 0;
        (void)hipGetDevice(&dev);
        (void)hipDeviceGetAttribute(&cus, hipDeviceAttributeMultiprocessorCount, dev);
        (void)hipFuncSetAttribute((const void*)fwd_megakernel, hipFuncAttributeMaxDynamicSharedMemorySize, LDS_BYTES);
        (void)hipOccupancyMaxActiveBlocksPerMultiprocessor(&per_cu, (const void*)fwd_megakernel, 512, LDS_BYTES);
        if (per_cu < 1) { fprintf(stderr, "kernel_launch: occupancy query says %d blocks per CU\n", per_cu); per_cu = 1; }
        (void)hipGetLastError();
        grid_blocks = cus * per_cu;
        if (grid_blocks > 256) grid_blocks = 256;
    }
    if (grid_blocks < 0) return;
    Params p{};
    for (int i = 0; i < 25; ++i) p.in[i] = (const float*)d_in[i];
    p.out = (float*)d_out; p.ws = (unsigned char*)d_ws;
    void* args[] = {&p};
    hipError_t e = hipLaunchCooperativeKernel((const void*)fwd_megakernel, dim3(grid_blocks), dim3(512), args, LDS_BYTES, stream);
    if (e != hipSuccess) fprintf(stderr, "cooperative launch failed: %s (grid %d)\n", hipGetErrorString(e), grid_blocks);
}
```
